# Optimizing an MI355X kernel written in HIP

```python
import jax, jax.numpy as jnp
from jax import lax
import numpy as np

D_MODEL = 1024
BATCH = 2
SEQ = 16384
DEPTH = 1

N_META = 16
N_HEADS = 8
HEAD_DIM = 128
ATTN_WIDTH = N_HEADS * HEAD_DIM
N_IDX_HEADS = 8
IDX_DIM = 64
TOPK_MAX = 256
CONV_WIDTH = D_MODEL
CONV_K = 3
D_FF = ((8 * D_MODEL // 3 + 255) // 256) * 256
Q_BLOCK = 128
EPS = 1e-6
IDX_SCALE = (N_IDX_HEADS ** -0.5) * (IDX_DIM ** -0.5)

_PROJ_SIZES = [ATTN_WIDTH, ATTN_WIDTH, ATTN_WIDTH,
               N_IDX_HEADS * IDX_DIM, IDX_DIM, N_IDX_HEADS,
               CONV_WIDTH, CONV_WIDTH, CONV_WIDTH,
               D_MODEL, D_MODEL]
PROJ_WIDTH = int(sum(_PROJ_SIZES))
PROJ_SPLITS = [int(s) for s in np.cumsum(_PROJ_SIZES)[:-1]]

kernel_name = "hybrid_dsa_shortconv_gated_block"


def rmsnorm(x, g):
    xf = x.astype(jnp.float32)
    y = xf * lax.rsqrt(jnp.mean(xf * xf, axis=-1, keepdims=True) + EPS)
    return (y * g.astype(jnp.float32)).astype(x.dtype)


def dsa_attention(q, k, v, q_idx, k_idx, w_idx):
    b, l = q.shape[0], q.shape[1]
    topk = min(TOPK_MAX, l // 4)
    n_blk = -(-l // Q_BLOCK)
    lp = n_blk * Q_BLOCK

    def pad(a):
        return jnp.pad(a, [(0, 0), (0, lp - l)] + [(0, 0)] * (a.ndim - 2))

    q, k, v, q_idx, k_idx, w_idx = (pad(a) for a in (q, k, v, q_idx, k_idx, w_idx))
    key_pos = jnp.arange(lp)

    def to_blocks(a):
        return jnp.moveaxis(a.reshape((b, n_blk, Q_BLOCK) + a.shape[2:]), 1, 0)

    def one_block(args):
        q_b, qi_b, w_b, start = args
        q_pos = start + jnp.arange(Q_BLOCK)
        visible = key_pos[None, :] <= q_pos[:, None]
        rel = jax.nn.relu(jnp.einsum('bthd,bsd->bths', qi_b, k_idx).astype(jnp.float32))
        score = jnp.einsum('bths,bth->bts', rel, w_b.astype(jnp.float32) * IDX_SCALE)
        score = jnp.where(visible[None], score, -jnp.inf)
        _, sel = lax.top_k(score, topk)
        k_sel = jax.vmap(lambda kb, ib: kb[ib])(k, sel)
        v_sel = jax.vmap(lambda vb, ib: vb[ib])(v, sel)
        valid = sel <= q_pos[None, :, None]
        logits = jnp.einsum('bthd,btkhd->bthk', q_b, k_sel).astype(jnp.float32) * (HEAD_DIM ** -0.5)
        logits = jnp.where(valid[:, :, None, :], logits, -jnp.inf)
        p = jax.nn.softmax(logits, axis=-1).astype(v_sel.dtype)
        return jnp.einsum('bthk,btkhd->bthd', p, v_sel)

    starts = jnp.arange(n_blk) * Q_BLOCK
    out = lax.map(one_block, (to_blocks(q), to_blocks(q_idx), to_blocks(w_idx), starts))
    out = jnp.moveaxis(out, 0, 1).reshape(b, lp, N_HEADS, HEAD_DIM)
    return out[:, :l]


def short_conv(u, w):
    return lax.conv_general_dilated(
        u, w[:, None, :].astype(u.dtype), window_strides=(1,), padding=[(CONV_K - 1, 0)],
        dimension_numbers=('NWC', 'WIO', 'NWC'), feature_group_count=u.shape[-1])


def setup_inputs(seed: int = 0) -> dict:
    key = jax.random.key(seed)
    ks = jax.random.split(key, 16)
    f32 = jnp.float32
    nrm = lambda k, shape, scale: (jax.random.normal(k, shape, f32) * scale)
    gain = lambda k: 1.0 + 0.02 * jax.random.normal(k, (DEPTH, D_MODEL), f32)
    return {
        "x": nrm(ks[0], (BATCH, SEQ, D_MODEL), 1.0),
        "meta_tokens": nrm(ks[1], (N_META, D_MODEL), 1.0),
        "norm_mix_g": gain(ks[2]),
        "w_in": nrm(ks[3], (DEPTH, D_MODEL, PROJ_WIDTH), D_MODEL ** -0.5),
        "w_attn_out": nrm(ks[4], (DEPTH, ATTN_WIDTH, D_MODEL), ATTN_WIDTH ** -0.5),
        "conv_w": nrm(ks[5], (DEPTH, CONV_K, CONV_WIDTH), CONV_K ** -0.5),
        "w_conv_out": nrm(ks[6], (DEPTH, CONV_WIDTH, D_MODEL), CONV_WIDTH ** -0.5),
        "w_out": nrm(ks[7], (DEPTH, D_MODEL, D_MODEL), D_MODEL ** -0.5),
        "norm_ffn_g": gain(ks[8]),
        "w_gate": nrm(ks[9], (DEPTH, D_MODEL, D_FF), D_MODEL ** -0.5),
        "w_up": nrm(ks[10], (DEPTH, D_MODEL, D_FF), D_MODEL ** -0.5),
        "w_down": nrm(ks[11], (DEPTH, D_FF, D_MODEL), D_FF ** -0.5),
        "norm_final_g": 1.0 + 0.02 * jax.random.normal(ks[12], (D_MODEL,), f32),
    }


def reference(x, meta_tokens, norm_mix_g, w_in, w_attn_out, conv_w, w_conv_out, w_out,
              norm_ffn_g, w_gate, w_up, w_down, norm_final_g):
    b = x.shape[0]
    meta = jnp.broadcast_to(meta_tokens[None].astype(x.dtype), (b, N_META, x.shape[-1]))
    h = jnp.concatenate([meta, x], axis=1)
    l = h.shape[1]
    for i in range(DEPTH):
        a = rmsnorm(h, norm_mix_g[i])
        proj = a @ w_in[i]
        q, k, v, qi, ki, wi, cu, cb, cc, ga, gb = jnp.split(proj, PROJ_SPLITS, axis=-1)
        y_attn = dsa_attention(q.reshape(b, l, N_HEADS, HEAD_DIM),
                               k.reshape(b, l, N_HEADS, HEAD_DIM),
                               v.reshape(b, l, N_HEADS, HEAD_DIM),
                               qi.reshape(b, l, N_IDX_HEADS, IDX_DIM), ki, wi)
        y_attn = y_attn.reshape(b, l, ATTN_WIDTH) @ w_attn_out[i]
        y_conv = (cb * short_conv(cc * cu, conv_w[i])) @ w_conv_out[i]
        mixed = jax.nn.sigmoid(ga) * y_attn + jax.nn.sigmoid(gb) * y_conv
        h = h + mixed @ w_out[i]
        f = rmsnorm(h, norm_ffn_g[i])
        h = h + (jax.nn.silu(f @ w_gate[i]) * (f @ w_up[i])) @ w_down[i]
    out = rmsnorm(h, norm_final_g)
    return out[:, N_META:]
```

```cpp
#include <hip/hip_runtime.h>
#include <hip/hip_bf16.h>
#include <hip/hip_cooperative_groups.h>
#include <cstdio>
namespace cg = cooperative_groups;

typedef unsigned short u16;
using bf16x8 = __attribute__((ext_vector_type(8))) __bf16;
using f32x4  = __attribute__((ext_vector_type(4))) float;
using f32x16 = __attribute__((ext_vector_type(16))) float;

constexpr int D = 1024, SEQ = 16384, NMETA = 16, LTOK = SEQ + NMETA;
constexpr int NB = 2, TOK = NB * LTOK;
constexpr int TOKP = 33024;
constexpr int NQ = NB * SEQ;
constexpr int DFF = 2816, PROJW = 8776, NPROJ = 8960;
constexpr int OFF_Q = 0, OFF_K = 1024, OFF_V = 2048, OFF_QI = 3072, OFF_KI = 3584, OFF_WI = 3648,
              OFF_CU = 3656, OFF_CB = 4680, OFF_CC = 5704, OFF_GA = 6728, OFF_GB = 7752;
constexpr float EPS = 1e-6f;
constexpr float IDX_SCALE = 0.04419417382415922f;
constexpr float ATT_SCALE = 0.08838834764831845f;
#ifndef PROBE_MODE
#define PROBE_MODE 0
#endif
constexpr int NTHREADS = 512;
constexpr int LDS_BYTES = 131072 + 4096;

constexpr size_t al256(size_t x) { return (x + 255) & ~(size_t)255; }
constexpr size_t WS_WIN  = 0;
constexpr size_t WS_WA   = WS_WIN + al256((size_t)NPROJ * D * 2);
constexpr size_t WS_WC   = WS_WA + al256((size_t)D * D * 2);
constexpr size_t WS_WO   = WS_WC + al256((size_t)D * D * 2);
constexpr size_t WS_WGU  = WS_WO + al256((size_t)D * D * 2);
constexpr size_t WS_WD   = WS_WGU + al256((size_t)2 * DFF * D * 2);
constexpr size_t WS_A0   = WS_WD + al256((size_t)D * DFF * 2);
constexpr size_t WS_Q    = WS_A0 + al256((size_t)TOKP * D * 2);
constexpr size_t WS_K    = WS_Q + al256((size_t)NQ * D * 2);
constexpr size_t WS_V    = WS_K + al256((size_t)TOK * D * 2);
constexpr size_t WS_P    = WS_V + al256((size_t)TOK * D * 2);
constexpr size_t WS_CB   = WS_P + al256((size_t)TOK * D * 2);
constexpr size_t WS_QI   = WS_CB + al256((size_t)NQ * D * 2);
constexpr size_t WS_KI   = WS_QI + al256((size_t)NQ * 512 * 2);
constexpr size_t WS_WI   = WS_KI + al256((size_t)TOKP * 64 * 2);
constexpr size_t WS_SEL  = WS_WI + al256((size_t)NQ * 8 * 4);
constexpr size_t WS_SS1  = WS_SEL + al256((size_t)NQ * 256 * 2);
constexpr size_t WS_SS2  = WS_SS1 + al256((size_t)NQ * 4);
constexpr size_t WS_CTL  = WS_SS2 + al256((size_t)NQ * 4);
constexpr size_t WS_END  = WS_CTL + 256;
constexpr size_t WS_K8   = WS_K;
constexpr size_t WS_V8   = WS_K + al256((size_t)TOK * D);
constexpr size_t WS_ACT  = WS_A0;
static_assert((size_t)NQ * DFF * 2 <= WS_V - WS_A0, "ACT overlay");
static_assert((size_t)NQ * D * 4 <= WS_P - WS_K, "T1 overlay");
static_assert(WS_END <= (size_t)536870912, "workspace");

struct Params {
    const float *x, *meta, *g_mix, *w_in, *w_attn_out, *conv_w, *w_conv_out, *w_out, *g_ffn, *w_gate, *w_up, *w_down, *g_final;
    float* out;
    unsigned char* ws;
    int ph_lo, ph_hi, probe, pad;
};

typedef __bf16 bf16x2_t __attribute__((ext_vector_type(2)));
typedef float f32x2_t __attribute__((ext_vector_type(2)));
__device__ __forceinline__ u16 f2bf(float f) { return __builtin_bit_cast(u16, (__bf16)f); }
__device__ __forceinline__ unsigned pack2(float a, float b) { const f32x2_t v = {a, b}; return __builtin_bit_cast(unsigned, __builtin_convertvector(v, bf16x2_t)); }
__device__ __forceinline__ float bflo(unsigned u) { return __uint_as_float(u << 16); }
__device__ __forceinline__ float bfhi(unsigned u) { return __uint_as_float(u & 0xFFFF0000u); }
__device__ __forceinline__ float sigmoidf_(float x) { return 1.f / (1.f + __expf(-x)); }
__device__ __forceinline__ float wave_sum(float v) {
#pragma unroll
    for (int o = 32; o > 0; o >>= 1) v += __shfl_xor(v, o);
    return v;
}

__device__ __forceinline__ int tid_fresh() { int t = threadIdx.x; asm volatile("" : "+v"(t)); return t; }

__device__ __forceinline__ void transpose_tile(const float* __restrict__ src, int srcN, int Kdim, u16* __restrict__ dst, int n0, int srccol0,
                               int nvalid, int k0, const float* __restrict__ kscale, float* tl, const int tid) {
    {
        const int tn = tid & 63, tk = tid >> 6;
#pragma unroll
        for (int i = 0; i < 8; ++i) {
            int k = tk + i * 8;
            float v = 0.f;
            if (tn < nvalid) {
                v = src[(size_t)(k0 + k) * srcN + srccol0 + tn];
                if (kscale) v *= kscale[k0 + k];
            }
            tl[k * 65 + tn] = v;
        }
    }
    __syncthreads();
    {
        const int n = tid >> 3, kk = (tid & 7) * 8;
        float v[8];
#pragma unroll
        for (int i = 0; i < 8; ++i) v[i] = tl[(kk + i) * 65 + n];
        uint4 o;
        o.x = pack2(v[0], v[1]); o.y = pack2(v[2], v[3]); o.z = pack2(v[4], v[5]); o.w = pack2(v[6], v[7]);
        *reinterpret_cast<uint4*>(dst + (size_t)(n0 + n) * Kdim + k0 + kk) = o;
    }
    __syncthreads();
}

__device__ __forceinline__ void phase_prep(const Params& p, unsigned char* lds) {
    float* tl = reinterpret_cast<float*>(lds);
    unsigned char* ws = p.ws;
    const int tid = tid_fresh();
    const int G = gridDim.x, bid = blockIdx.x;
    constexpr int T_IN = (NPROJ / 64) * 16;
    constexpr int T_SQ = 16 * 16;
    constexpr int T_GU = (2 * DFF / 64) * 16;
    constexpr int T_DN = 16 * (DFF / 64);
    constexpr int T_ALL = T_IN + 3 * T_SQ + T_GU + T_DN;
    for (int t = bid; t < T_ALL; t += G) {
        if (t < T_IN) {
            int g64 = t >> 4, kt = t & 15;
            int n0 = g64 * 64, pn = n0 >> 8, lc = n0 & 255;
            int sc0 = 0, nv = 64;
            if (pn < 12) sc0 = n0;
            else if (pn < 20) { int c0 = (pn - 12) * 128; sc0 = (lc < 128) ? (OFF_CU + c0 + lc) : (OFF_CC + c0 + lc - 128); }
            else if (pn < 24) sc0 = OFF_CB + (pn - 20) * 256 + lc;
            else if (pn < 28) sc0 = OFF_GA + (pn - 24) * 256 + lc;
            else if (pn < 32) sc0 = OFF_GB + (pn - 28) * 256 + lc;
            else if (pn < 34) sc0 = OFF_QI + (pn - 32) * 256 + lc;
            else { if (lc == 0) { sc0 = OFF_KI; nv = 64; } else if (lc == 64) { sc0 = OFF_WI; nv = 8; } else { sc0 = 0; nv = 0; } }
            transpose_tile(p.w_in, PROJW, D, (u16*)(ws + WS_WIN), n0, sc0, nv, kt * 64, nullptr, tl, tid);
        } else if (t < T_IN + 3 * T_SQ) {
            int u = t - T_IN, which = u / T_SQ, v = u % T_SQ;
            const float* src = which == 0 ? p.w_attn_out : (which == 1 ? p.w_conv_out : p.w_out);
            u16* dst = (u16*)(ws + (which == 0 ? WS_WA : (which == 1 ? WS_WC : WS_WO)));
            int n0 = (v >> 4) * 64, k0 = (v & 15) * 64;
            transpose_tile(src, D, D, dst, n0, n0, 64, k0, nullptr, tl, tid);
        } else if (t < T_IN + 3 * T_SQ + T_GU) {
            int u = t - T_IN - 3 * T_SQ;
            int g64 = u >> 4, kt = u & 15;
            int n0 = g64 * 64, pn = n0 >> 8, lc = n0 & 255;
            const float* src = (lc < 128) ? p.w_gate : p.w_up;
            int sc0 = pn * 128 + (lc & 127);
            transpose_tile(src, DFF, D, (u16*)(ws + WS_WGU), n0, sc0, 64, kt * 64, p.g_ffn, tl, tid);
        } else {
            int u = t - T_IN - 3 * T_SQ - T_GU;
            int nt = u / (DFF / 64), kt = u % (DFF / 64);
            transpose_tile(p.w_down, D, DFF, (u16*)(ws + WS_WD), nt * 64, nt * 64, 64, kt * 64, nullptr, tl, tid);
        }
    }
    const int lane = tid & 63, wave = tid >> 6;
    u16* A0 = (u16*)(ws + WS_A0);
    for (int r = bid * 8 + wave; r < TOKP; r += G * 8) {
        uint2 o[4];
        if (r < TOK) {
            int b = r / LTOK, pos = r - b * LTOK;
            const float* src = (pos < NMETA) ? (p.meta + (size_t)pos * D) : (p.x + ((size_t)b * SEQ + (pos - NMETA)) * D);
            float4 v[4];
            float ss = 0.f;
#pragma unroll
            for (int i = 0; i < 4; ++i) {
                v[i] = *reinterpret_cast<const float4*>(src + i * 256 + lane * 4);
                ss += v[i].x * v[i].x + v[i].y * v[i].y + v[i].z * v[i].z + v[i].w * v[i].w;
            }
            ss = wave_sum(ss);
            float rstd = rsqrtf(ss * (1.f / D) + EPS);
#pragma unroll
            for (int i = 0; i < 4; ++i) {
                float4 g = *reinterpret_cast<const float4*>(p.g_mix + i * 256 + lane * 4);
                o[i].x = pack2(v[i].x * rstd * g.x, v[i].y * rstd * g.y);
                o[i].y = pack2(v[i].z * rstd * g.z, v[i].w * rstd * g.w);
            }
        } else {
#pragma unroll
            for (int i = 0; i < 4; ++i) { o[i].x = 0; o[i].y = 0; }
        }
#pragma unroll
        for (int i = 0; i < 4; ++i) *reinterpret_cast<uint2*>(A0 + (size_t)r * D + i * 256 + lane * 4) = o[i];
    }
    float* ss1 = (float*)(ws + WS_SS1);
    float* ss2 = (float*)(ws + WS_SS2);
    for (int i = bid * NTHREADS + tid; i < NQ; i += G * NTHREADS) { ss1[i] = 0.f; ss2[i] = 0.f; }
}

constexpr int BM = 256, BK = 64, HALF = 128, NXCD = 8, HT = HALF * BK;

__device__ __forceinline__ int lds_byte(int r, int c) {
    int st = (r >> 4) * 2 + (c >> 5), rr = r & 15, cc = c & 31, ob = rr * 64 + cc * 2;
    return st * 1024 + (ob ^ (((ob >> 9) & 1) << 5));
}
__device__ __forceinline__ void stage_rc(int b, int& R, int& C) {
    int st = b / 1024, sb = b % 1024, swz = sb ^ (((sb >> 9) & 1) << 5);
    R = (st >> 1) * 16 + swz / 64; C = (st & 1) * 32 + (swz % 64) / 2;
}

enum { EPI_PROJ = 0, EPI_T1 = 1, EPI_MIX = 2, EPI_H1 = 3, EPI_GU = 4, EPI_DOWN = 5 };

struct EpiArgs {
    unsigned char* ws;
    const float* x;
    float* out;
};

template <int EPI, int M, int N, int K>
__device__ __forceinline__ void gemm_phase(const u16* __restrict__ A, const u16* __restrict__ Bt,
                           const EpiArgs ea, unsigned char* ldsraw, const u16* __restrict__ A2 = nullptr, const u16* __restrict__ Bt2 = nullptr) {
    u16* shm = reinterpret_cast<u16*>(ldsraw);
#define SA(b, h) (shm + ((b) * 2 + (h)) * HT)
#define SB(b, h) (shm + (4 + (b) * 2 + (h)) * HT)
#define SAO(b, h) ((unsigned)(((b) * 2 + (h)) * HT * 2))
#define SBO(b, h) ((unsigned)((4 + (b) * 2 + (h)) * HT * 2))
#define STAGE(SLOTOFF, BASE, br, kt) do { const u16* _gp = (BASE) + (long)(br) * K + (long)(kt) * BK; \
    const unsigned _m0 = lds_wave_base + (SLOTOFF); \
    asm volatile("s_mov_b32 m0, %0\n\ts_nop 0\n\tglobal_load_lds_dwordx4 %1, %2" :: "s"(_m0), "v"(voff), "s"(_gp) : "memory"); \
    asm volatile("s_mov_b32 m0, %0\n\ts_nop 0\n\tglobal_load_lds_dwordx4 %1, %2" :: "s"(_m0 + 8192u), "v"(voff), "s"(_gp + 64 * K) : "memory"); } while (0)
#define LDA(dst, b, h) for (int m = 0; m < 4; ++m) for (int k = 0; k < 2; ++k) \
    dst[m][k] = *reinterpret_cast<const bf16x8*>((char*)SA(b, h) + lds_byte(wr * 64 + m * 16 + fr, k * 32 + fq * 8))
#define LDB(dst, b, h) for (int n = 0; n < 2; ++n) for (int k = 0; k < 2; ++k) \
    dst[n][k] = *reinterpret_cast<const bf16x8*>((char*)SB(b, h) + lds_byte(wc * 32 + n * 16 + fr, k * 32 + fq * 8))
#define MMA(ai, bj, At, Bq) do { __builtin_amdgcn_s_setprio(1); \
    for (int m = 0; m < 4; ++m) for (int n = 0; n < 2; ++n) for (int k = 0; k < 2; ++k) \
      acc[ai][bj][m][n] = __builtin_amdgcn_mfma_f32_16x16x32_bf16(At[m][k], Bq[n][k], acc[ai][bj][m][n], 0, 0, 0); \
    __builtin_amdgcn_s_setprio(0); } while (0)
#define WAIT_V(n) asm volatile("s_waitcnt vmcnt(" #n ")" ::: "memory")
#define WAIT_L(n) asm volatile("s_waitcnt lgkmcnt(" #n ")" ::: "memory")
#define BAR __builtin_amdgcn_s_barrier()
#define SCHED __builtin_amdgcn_sched_barrier(0)

    constexpr int nM = M / BM, nN = N / BM, nwg = nM * nN;
    const int gtid = tid_fresh();
    unsigned voff;
    { int _r, _c; stage_rc(gtid * 16, _r, _c); voff = (unsigned)((_r * K + _c) * 2); }
    const unsigned lds_wave_base = __builtin_amdgcn_readfirstlane(
        (unsigned)(unsigned long long)(__attribute__((address_space(3))) unsigned char*)ldsraw + (unsigned)(gtid >> 6) * 1024u);
    const int wid = gtid >> 6, lane = gtid & 63, wr = wid >> 2, wc = wid & 3, fr = lane & 15, fq = lane >> 4;
    constexpr int nt = K / BK;
    constexpr int WGM = (EPI == EPI_PROJ) ? 2 : 8;
#define TILE_RC(T, PM, PN) do { int wgid_ = (T); \
        { int q = nwg / NXCD, r = nwg % NXCD, xcd = wgid_ % NXCD, off = wgid_ / NXCD; \
          wgid_ = (xcd < r ? xcd * (q + 1) : r * (q + 1) + (xcd - r) * q) + off; } \
        constexpr int nig = WGM * nN; const int gid = wgid_ / nig, fm = gid * WGM, gsz = min(nM - fm, WGM); \
        PM = fm + ((wgid_ % nig) % gsz); PN = (wgid_ % nig) / gsz; } while (0)
    constexpr bool PREFETCH_NEXT = (EPI != EPI_PROJ);
    bool prefetched = false;
    for (int tile = blockIdx.x; tile < nwg; tile += gridDim.x) {
        int pm, pn;
        TILE_RC(tile, pm, pn);
        const int brow = pm * BM, bcol = pn * BM;
        f32x4 acc[2][2][4][2] = {};
        bf16x8 At[4][2], B0[2][2], B1[2][2];
        constexpr int NPASS = (EPI == EPI_MIX) ? 2 : 1;
#pragma unroll 1
        for (int pass = 0; pass < NPASS; ++pass) {
        const u16* Ap = pass ? A2 : A;
        const u16* Bp = pass ? Bt2 : Bt;
        if (!(prefetched && pass == 0)) {
            STAGE(SBO(0, 0), Bp, bcol, 0); STAGE(SAO(0, 0), Ap, brow, 0);
            STAGE(SBO(0, 1), Bp, bcol + HALF, 0); STAGE(SAO(0, 1), Ap, brow + HALF, 0);
        }
        if (wr == 1) BAR;
        WAIT_V(4); BAR;
        STAGE(SBO(1, 0), Bp, bcol, 1); STAGE(SAO(1, 0), Ap, brow, 1); STAGE(SBO(1, 1), Bp, bcol + HALF, 1);
        WAIT_V(6); BAR;
        for (int t = 0; t < nt - 2; t += 2) {
            LDB(B0, 0, 0); SCHED; LDA(At, 0, 0); STAGE(SAO(1, 1), Ap, brow + HALF, t + 1);
            WAIT_L(8); BAR; WAIT_L(0); MMA(0, 0, At, B0); BAR; SCHED;
            LDB(B1, 0, 1); STAGE(SBO(0, 0), Bp, bcol, t + 2);
            BAR; WAIT_L(0); MMA(0, 1, At, B1); BAR;
            LDA(At, 0, 1); STAGE(SAO(0, 0), Ap, brow, t + 2);
            BAR; WAIT_L(0); MMA(1, 0, At, B0); BAR; SCHED;
            STAGE(SBO(0, 1), Bp, bcol + HALF, t + 2);
            WAIT_V(6); BAR; MMA(1, 1, At, B1); BAR;
            LDB(B0, 1, 0); SCHED; LDA(At, 1, 0); STAGE(SAO(0, 1), Ap, brow + HALF, t + 2);
            WAIT_L(8); BAR; WAIT_L(0); MMA(0, 0, At, B0); BAR; SCHED;
            LDB(B1, 1, 1); STAGE(SBO(1, 0), Bp, bcol, t + 3);
            BAR; WAIT_L(0); MMA(0, 1, At, B1); BAR;
            LDA(At, 1, 1); STAGE(SAO(1, 0), Ap, brow, t + 3);
            BAR; WAIT_L(0); MMA(1, 0, At, B0); BAR; SCHED;
            STAGE(SBO(1, 1), Bp, bcol + HALF, t + 3);
            WAIT_V(6); BAR; MMA(1, 1, At, B1); BAR;
        }
        { LDB(B0, 0, 0); LDA(At, 0, 0); STAGE(SAO(1, 1), Ap, brow + HALF, nt - 1);
          BAR; WAIT_L(0); MMA(0, 0, At, B0); BAR;
          LDB(B1, 0, 1); BAR; WAIT_L(0); MMA(0, 1, At, B1); BAR;
          LDA(At, 0, 1); WAIT_V(4); BAR; WAIT_L(0); MMA(1, 0, At, B0); MMA(1, 1, At, B1); BAR; }
        { LDB(B0, 1, 0); LDA(At, 1, 0); WAIT_V(2); BAR; WAIT_L(0); MMA(0, 0, At, B0); BAR;
          LDB(B1, 1, 1); WAIT_V(0); BAR; WAIT_L(0); MMA(0, 1, At, B1); BAR;
          LDA(At, 1, 1); BAR; WAIT_L(0); MMA(1, 0, At, B0); MMA(1, 1, At, B1); BAR; }
        if (wr == 0) BAR;
        if (NPASS == 2 && pass == 0) {
            int s_row0 = wr * 64 + fq * 4, s_lc0 = wc * 32 + fr;
            asm volatile("" : "+v"(s_row0), "+v"(s_lc0));
#pragma unroll
            for (int ai = 0; ai < 2; ++ai)
#pragma unroll
            for (int m = 0; m < 4; ++m)
#pragma unroll
            for (int j = 0; j < 4; ++j) {
                const size_t ro = (size_t)(brow + ai * HALF + s_row0 + m * 16 + j) * D + bcol + s_lc0;
                const u16* ga = (const u16*)ea.out + ro;
                const u16* gb = (const u16*)ea.out + (size_t)NQ * D + ro;
#pragma unroll
                for (int bj = 0; bj < 2; ++bj)
#pragma unroll
                for (int n = 0; n < 2; ++n)
                    acc[ai][bj][m][n][j] *= bflo(ga[bj * 128 + n * 16]) * __builtin_amdgcn_rcpf(bflo(gb[bj * 128 + n * 16]));
            }
            __syncthreads();
        }
        }
        prefetched = false;
        if (PREFETCH_NEXT && tile + (int)gridDim.x < nwg) {
            int pm2, pn2;
            TILE_RC(tile + (int)gridDim.x, pm2, pn2);
            const int brow2 = pm2 * BM, bcol2 = pn2 * BM;
            STAGE(SBO(0, 0), Bt, bcol2, 0); STAGE(SAO(0, 0), A, brow2, 0);
            STAGE(SBO(0, 1), Bt, bcol2 + HALF, 0); STAGE(SAO(0, 1), A, brow2 + HALF, 0);
            prefetched = true;
        }

        unsigned char* ws = ea.ws;
        int e_row0 = wr * 64 + fq * 4, e_lc0 = wc * 32 + fr;
        asm volatile("" : "+v"(e_row0), "+v"(e_lc0));
        bool staged_done = false;
        if constexpr (EPI == EPI_PROJ) {
            if (pn != 34) {
                staged_done = true;
                const bool is8 = (pn >= 4 && pn < 12);
                const bool isP = (pn >= 12 && pn < 20);
                const bool isG = (pn >= 24 && pn < 32);
                int e_tid = gtid;
                asm volatile("" : "+v"(e_tid));
#define PROJ_STAGE2(CPR, STRIDE) do { \
                    for (int pc = e_tid; pc < 128 * (CPR); pc += NTHREADS) { \
                        const int r = pc / (CPR), cc = pc - r * (CPR); \
                        const int row = brow + ai * HALF + r; \
                        if (row < TOK) { \
                            const int b = row >= LTOK ? 1 : 0, pos = row - b * LTOK; \
                            const bool isq = pos >= NMETA; \
                            const size_t qn = (size_t)b * SEQ + (pos - NMETA); \
                            const uint4 v = *reinterpret_cast<const uint4*>(ldsraw + r * (STRIDE) + cc * 16); \
                            unsigned char* dst = nullptr; \
                            if (pn < 4) { if (isq) dst = ws + WS_Q + (qn * D + pn * 256 + cc * 8) * 2; } \
                            else if (pn < 12) { const int head = (pn & 3) * 2 + (cc >> 3); \
                                dst = ws + (pn < 8 ? WS_K8 : WS_V8) + ((size_t)(b * 8 + head) * LTOK + pos) * 128 + (cc & 7) * 16; } \
                            else if (pn < 20) dst = ws + WS_P + ((size_t)row * D + (pn - 12) * 128 + cc * 8) * 2; \
                            else if (pn < 24) { if (isq) dst = ws + WS_CB + (qn * D + (pn - 20) * 256 + cc * 8) * 2; } \
                            else if (pn < 32) { if (isq) dst = (unsigned char*)ea.out + ((size_t)(pn >= 28 ? 1 : 0) * NQ * D + qn * D + (pn & 3) * 256 + cc * 8) * 2; } \
                            else { if (isq) dst = ws + WS_QI + (qn * 512 + (pn - 32) * 256 + cc * 8) * 2; } \
                            if (dst) { typedef unsigned u32x4 __attribute__((ext_vector_type(4))); u32x4 vv = {v.x, v.y, v.z, v.w}; \
                                __builtin_nontemporal_store(vv, reinterpret_cast<u32x4*>(dst)); } \
                        } } } while (0)
#pragma unroll
                for (int ai = 0; ai < 2; ++ai) {
                    if (is8) {
#pragma unroll
                        for (int m = 0; m < 4; ++m)
#pragma unroll
                        for (int j = 0; j < 4; ++j) {
                            unsigned char* d = ldsraw + (e_row0 + m * 16 + j) * 272 + e_lc0;
#pragma unroll
                            for (int bj = 0; bj < 2; ++bj)
#pragma unroll
                            for (int n = 0; n < 2; ++n) {
                                const float v = acc[ai][bj][m][n][j];
                                d[bj * 128 + n * 16] = (unsigned char)(__builtin_amdgcn_cvt_pk_fp8_f32(v, v, 0, false) & 0xFF);
                            }
                        }
                    } else if (isP) {
#pragma unroll
                        for (int m = 0; m < 4; ++m)
#pragma unroll
                        for (int j = 0; j < 4; ++j) {
                            u16* d = reinterpret_cast<u16*>(ldsraw + (e_row0 + m * 16 + j) * 544) + e_lc0;
#pragma unroll
                            for (int n = 0; n < 2; ++n) d[n * 16] = f2bf(acc[ai][0][m][n][j] * acc[ai][1][m][n][j]);
                        }
                    } else {
#pragma unroll
                        for (int m = 0; m < 4; ++m)
#pragma unroll
                        for (int j = 0; j < 4; ++j) {
                            u16* d = reinterpret_cast<u16*>(ldsraw + (e_row0 + m * 16 + j) * 544) + e_lc0;
#pragma unroll
                            for (int bj = 0; bj < 2; ++bj)
#pragma unroll
                            for (int n = 0; n < 2; ++n) {
                                float v = acc[ai][bj][m][n][j];
                                if (isG) v = sigmoidf_(v);
                                d[bj * 128 + n * 16] = f2bf(v);
                            }
                        }
                    }
                    __syncthreads();
                    if (is8) PROJ_STAGE2(16, 272); else if (isP) PROJ_STAGE2(16, 544); else PROJ_STAGE2(32, 544);
                    __syncthreads();
                }
#undef PROJ_STAGE2
            }
        }
        if (!staged_done)
#pragma unroll
        for (int ai = 0; ai < 2; ++ai)
#pragma unroll
        for (int m = 0; m < 4; ++m)
#pragma unroll
        for (int j = 0; j < 4; ++j) {
            const int row = brow + ai * HALF + e_row0 + m * 16 + j;
            const int lc0 = e_lc0;
            if constexpr (EPI == EPI_PROJ) {
                if (row < TOK) {
                    const int b = row / LTOK, pos = row - b * LTOK;
                    const bool isq = pos >= NMETA;
                    const size_t qn = (size_t)b * SEQ + (pos - NMETA);
                    if (pn < 4) {
                        if (isq) {
                            u16* d = (u16*)(ws + WS_Q) + qn * D + pn * 256 + lc0;
#pragma unroll
                            for (int bj = 0; bj < 2; ++bj)
#pragma unroll
                            for (int n = 0; n < 2; ++n) d[bj * 128 + n * 16] = f2bf(acc[ai][bj][m][n][j]);
                        }
                    } else if (pn < 12) {
                        unsigned char* base = ws + (pn < 8 ? WS_K8 : WS_V8);
#pragma unroll
                        for (int bj = 0; bj < 2; ++bj) {
                            const int head = (pn & 3) * 2 + bj;
                            unsigned char* d = base + ((size_t)(b * 8 + head) * LTOK + pos) * 128 + lc0;
#pragma unroll
                            for (int n = 0; n < 2; ++n) {
                                const float v = acc[ai][bj][m][n][j];
                                d[n * 16] = (unsigned char)(__builtin_amdgcn_cvt_pk_fp8_f32(v, v, 0, false) & 0xFF);
                            }
                        }
                    } else if (pn < 20) {
                        u16* d = (u16*)(ws + WS_P) + (size_t)row * D + (pn - 12) * 128 + lc0;
#pragma unroll
                        for (int n = 0; n < 2; ++n) d[n * 16] = f2bf(acc[ai][0][m][n][j] * acc[ai][1][m][n][j]);
                    } else if (pn < 32) {
                        if (isq) {
                            if (pn < 24) {
                                u16* d = (u16*)(ws + WS_CB) + qn * D + (pn - 20) * 256 + lc0;
#pragma unroll
                                for (int bj = 0; bj < 2; ++bj)
#pragma unroll
                                for (int n = 0; n < 2; ++n) d[bj * 128 + n * 16] = f2bf(acc[ai][bj][m][n][j]);
                            } else {
                                u16* d = (u16*)ea.out + (size_t)(pn >= 28 ? 1 : 0) * NQ * D + qn * D + (pn & 3) * 256 + lc0;
#pragma unroll
                                for (int bj = 0; bj < 2; ++bj)
#pragma unroll
                                for (int n = 0; n < 2; ++n) d[bj * 128 + n * 16] = f2bf(sigmoidf_(acc[ai][bj][m][n][j]));
                            }
                        }
                    } else if (pn < 34) {
                        if (isq) {
                            u16* d = (u16*)(ws + WS_QI) + qn * 512 + (pn - 32) * 256 + lc0;
#pragma unroll
                            for (int bj = 0; bj < 2; ++bj)
#pragma unroll
                            for (int n = 0; n < 2; ++n) d[bj * 128 + n * 16] = f2bf(acc[ai][bj][m][n][j]);
                        }
                    } else {
#pragma unroll
                        for (int n = 0; n < 2; ++n) {
                            const int lc = lc0 + n * 16;
                            const float v = acc[ai][0][m][n][j];
                            if (lc < 64) ((u16*)(ws + WS_KI))[(size_t)row * 64 + lc] = f2bf(v);
                            else if (lc < 72 && isq) ((float*)(ws + WS_WI))[qn * 8 + (lc - 64)] = v * IDX_SCALE;
                        }
                    }
                }
            } else if constexpr (EPI == EPI_T1) {
                const u16* ga = (const u16*)ea.out + (size_t)row * D + bcol + lc0;
                float* d = (float*)(ws + WS_K) + (size_t)row * D + bcol + lc0;
#pragma unroll
                for (int bj = 0; bj < 2; ++bj)
#pragma unroll
                for (int n = 0; n < 2; ++n) d[bj * 128 + n * 16] = bflo(ga[bj * 128 + n * 16]) * acc[ai][bj][m][n][j];
            } else if constexpr (EPI == EPI_MIX) {
                const u16* gb = (const u16*)ea.out + (size_t)NQ * D + (size_t)row * D + bcol + lc0;
                u16* d = (u16*)(ws + WS_P) + (size_t)row * D + bcol + lc0;
#pragma unroll
                for (int bj = 0; bj < 2; ++bj)
#pragma unroll
                for (int n = 0; n < 2; ++n)
                    d[bj * 128 + n * 16] = f2bf(bflo(gb[bj * 128 + n * 16]) * acc[ai][bj][m][n][j]);
            } else if constexpr (EPI == EPI_H1) {
                const float* xr = ea.x + (size_t)row * D + bcol + lc0;
                u16* hb = (u16*)(ws + WS_CB) + (size_t)row * D + bcol + lc0;
                float ss = 0.f;
#pragma unroll
                for (int bj = 0; bj < 2; ++bj)
#pragma unroll
                for (int n = 0; n < 2; ++n) {
                    float v = xr[bj * 128 + n * 16] + acc[ai][bj][m][n][j];
                    hb[bj * 128 + n * 16] = f2bf(v);
                    ss += v * v;
                }
                ss += __shfl_xor(ss, 1); ss += __shfl_xor(ss, 2); ss += __shfl_xor(ss, 4); ss += __shfl_xor(ss, 8);
                if ((e_lc0 & 15) == 0) atomicAdd((float*)(ws + WS_SS1) + row, ss);
            } else if constexpr (EPI == EPI_GU) {
                const float rstd = rsqrtf(((const float*)(ws + WS_SS1))[row] * (1.f / D) + EPS);
                u16* d = (u16*)(ws + WS_ACT) + (size_t)row * DFF + pn * 128 + lc0;
#pragma unroll
                for (int n = 0; n < 2; ++n) {
                    float g = acc[ai][0][m][n][j] * rstd, u = acc[ai][1][m][n][j] * rstd;
                    d[n * 16] = f2bf(g * sigmoidf_(g) * u);
                }
            } else if constexpr (EPI == EPI_DOWN) {
                float* d = ea.out + (size_t)row * D + bcol + lc0;
                const u16* hb = (const u16*)(ws + WS_CB) + (size_t)row * D + bcol + lc0;
                float ss = 0.f;
#pragma unroll
                for (int bj = 0; bj < 2; ++bj)
#pragma unroll
                for (int n = 0; n < 2; ++n) {
                    float v = bflo(hb[bj * 128 + n * 16]) + acc[ai][bj][m][n][j];
                    d[bj * 128 + n * 16] = v;
                    ss += v * v;
                }
                ss += __shfl_xor(ss, 1); ss += __shfl_xor(ss, 2); ss += __shfl_xor(ss, 4); ss += __shfl_xor(ss, 8);
                if ((e_lc0 & 15) == 0) atomicAdd((float*)(ws + WS_SS2) + row, ss);
            }
        }
        __syncthreads();
    }
#undef TILE_RC
#undef SA
#undef SB
#undef SAO
#undef SBO
#undef STAGE
#undef LDA
#undef LDB
#undef MMA
}

constexpr int BIN_BASE = 117 << 5, BIN_TOP = (133 << 5) - 1;
__device__ __forceinline__ int score_bin(float x) {
    unsigned u = __float_as_uint(x);
    int e = (int)((u & 0x7FFFFFFFu) >> 18);
    e = min(max(e, BIN_BASE), BIN_TOP) - BIN_BASE;
    return (u >> 31) ? (511 - e) : (512 + e);
}
typedef float f32x2 __attribute__((ext_vector_type(2)));
__device__ __forceinline__ float bin_lower_edge(int bin) {
    if (bin < 0) return -INFINITY;
    if (bin >= 512) { const int m = bin - 512; return m == 0 ? 0.f : __uint_as_float((unsigned)(m + BIN_BASE) << 18); }
    const int m = 511 - bin;
    return (m == 511) ? -INFINITY : -__uint_as_float((unsigned)(m + 1 + BIN_BASE) << 18);
}
__device__ __forceinline__ float relu1(float x) { return __builtin_amdgcn_fmed3f(x, 0.f, __builtin_inff()); }

__device__ __forceinline__ void score_chunk(const bf16x8 (&ak)[2][2], const bf16x8 (&bq)[8][2], const bf16x8 (&bl)[2][2],
                                            const float (&wh)[8], float (&sc)[8]) {
#pragma unroll
    for (int sub = 0; sub < 2; ++sub) {
        f32x4 lin = {0.f, 0.f, 0.f, 0.f};
        lin = __builtin_amdgcn_mfma_f32_16x16x32_bf16(ak[sub][0], bl[0][0], lin, 0, 0, 0);
        lin = __builtin_amdgcn_mfma_f32_16x16x32_bf16(ak[sub][1], bl[0][1], lin, 0, 0, 0);
        lin = __builtin_amdgcn_mfma_f32_16x16x32_bf16(ak[sub][0], bl[1][0], lin, 0, 0, 0);
        lin = __builtin_amdgcn_mfma_f32_16x16x32_bf16(ak[sub][1], bl[1][1], lin, 0, 0, 0);
#pragma unroll
        for (int i = 0; i < 4; ++i) sc[sub * 4 + i] = lin[i];
    }
#pragma unroll
    for (int h = 0; h < 8; ++h) {
#pragma unroll
        for (int sub = 0; sub < 2; ++sub) {
            f32x4 acc = {0.f, 0.f, 0.f, 0.f};
            acc = __builtin_amdgcn_mfma_f32_16x16x32_bf16(ak[sub][0], bq[h][0], acc, 0, 0, 0);
            acc = __builtin_amdgcn_mfma_f32_16x16x32_bf16(ak[sub][1], bq[h][1], acc, 0, 0, 0);
#pragma unroll
            for (int i = 0; i < 4; ++i) sc[sub * 4 + i] = __builtin_fmaf(__builtin_fabsf(acc[i]), wh[h], sc[sub * 4 + i]);
        }
    }
}

struct IdxCtx {
    const u16* KIb; int l16, kq, ql, pos, wg, wave;
    unsigned* hist; int* nsel; int* ncand; float* candv; int* candi; u16* selq;
    unsigned ring_lds;
    const unsigned char* ring;
    unsigned dma_voff;
    unsigned long long* logq;
    int* nlog;
};
constexpr int LOGCAP = 1024;

template <int PASS, bool LOG = false>
__device__ __forceinline__ void idx_chunks(const IdxCtx& cx, const int cbeg, const int cend, const bf16x8 (&bq)[8][2],
                                           const bf16x8 (&bl)[2][2], const float (&w)[8], const float thr, const int mytb) {
    const int nIter = (cend - cbeg + 3) >> 2;
    if (nIter <= 0) return;
    const unsigned char* gsrc = reinterpret_cast<const unsigned char*>(cx.KIb) + (size_t)cbeg * 4096 + (size_t)cx.wave * 2048;
#define IDX_DMA(stage) do { const int _st = min((stage), nIter - 1); \
        const unsigned char* _g = gsrc + (size_t)_st * 16384; \
        const unsigned _m0 = cx.ring_lds + (unsigned)(((stage) & 3) * 16384 + cx.wave * 2048); \
        asm volatile("s_mov_b32 m0, %0\n\ts_nop 0\n\tglobal_load_lds_dwordx4 %1, %2" :: "s"(_m0), "v"(cx.dma_voff), "s"(_g) : "memory"); \
        asm volatile("s_mov_b32 m0, %0\n\ts_nop 0\n\tglobal_load_lds_dwordx4 %1, %2" :: "s"(_m0 + 1024u), "v"(cx.dma_voff), "s"(_g + 1024) : "memory"); } while (0)
    IDX_DMA(0); IDX_DMA(1); IDX_DMA(2);
#pragma unroll 1
    for (int i = 0; i < nIter; ++i) {
        asm volatile("s_waitcnt vmcnt(4)" ::: "memory");
        __builtin_amdgcn_s_barrier();
        IDX_DMA(i + 3);
        const int c = cbeg + 4 * i + cx.wg;
        if (c < cend) {
            const unsigned char* slot = cx.ring + (i & 3) * 16384 + cx.wg * 4096;
            bf16x8 ak[2][2];
#pragma unroll
            for (int sub = 0; sub < 2; ++sub)
#pragma unroll
            for (int ks = 0; ks < 2; ++ks) {
                const int key = sub * 16 + cx.l16, piece = ks * 4 + cx.kq;
                ak[sub][ks] = *reinterpret_cast<const bf16x8*>(slot + key * 128 + ((piece ^ (key & 7)) * 16));
            }
            float sc[8];
            score_chunk(ak, bq, bl, w, sc);
#pragma unroll
            for (int e = 0; e < 8; ++e) {
                const int s = 32 * c + 16 * (e >> 2) + 4 * cx.kq + (e & 3);
                if (s <= cx.pos && sc[e] >= thr) {
                    const int bin = score_bin(sc[e]);
                    if (PASS == 1) {
                        atomicAdd(&cx.hist[cx.ql * 512 + (bin >> 1)], 1u << ((bin & 1) * 16));
                        if (LOG) {
                            const int ls = atomicAdd(&cx.nlog[cx.ql], 1);
                            if (ls < LOGCAP) cx.logq[ls] = (unsigned long long)__float_as_uint(sc[e]) | ((unsigned long long)(unsigned)s << 32);
                        }
                    } else {
                        if (bin > mytb) {
                            const int slot2 = atomicAdd(&cx.nsel[cx.ql], 1);
                            if (slot2 < 256) cx.selq[slot2] = (u16)s;
                        } else if (bin == mytb) {
                            const int cidx = atomicAdd(&cx.ncand[cx.ql], 1);
                            if (cidx < 256) { cx.candv[cx.ql * 256 + cidx] = sc[e]; cx.candi[cx.ql * 256 + cidx] = s; }
                        }
                    }
                }
            }
        }
    }
    asm volatile("s_waitcnt vmcnt(0)" ::: "memory");
    __syncthreads();
#undef IDX_DMA
}

__device__ __forceinline__ void idx_threshold_scan(const unsigned* hist, int* tbv, int* cabv, const int wave, const int lane) {
#pragma unroll 1
    for (int qq = 0; qq < 4; ++qq) {
        const int q = wave * 4 + qq;
        const unsigned* hq = hist + q * 512 + lane * 8;
        unsigned wd[8];
        int mine = 0;
#pragma unroll
        for (int i = 0; i < 8; ++i) { wd[i] = hq[i]; mine += (int)(wd[i] & 0xFFFFu) + (int)(wd[i] >> 16); }
        int suf = mine;
#pragma unroll
        for (int o = 1; o < 64; o <<= 1) { int t = __shfl_down(suf, o); if (lane + o < 64) suf += t; }
        const unsigned long long mk = __ballot(suf >= 256);
        if (mk == 0ull) { if (lane == 0) { tbv[q] = -1; cabv[q] = 0; } }
        else {
            const int ls = 63 - __clzll((long long)mk);
            if (lane == ls) {
                int cum = suf - mine, tb = lane * 16, cab = cum;
                bool found = false;
#pragma unroll
                for (int i = 7; i >= 0; --i) {
                    const int chi = (int)(wd[i] >> 16), clo = (int)(wd[i] & 0xFFFFu);
                    if (!found) { if (cum + chi >= 256) { tb = lane * 16 + 2 * i + 1; cab = cum; found = true; } else cum += chi; }
                    if (!found) { if (cum + clo >= 256) { tb = lane * 16 + 2 * i; cab = cum; found = true; } else cum += clo; }
                }
                tbv[q] = tb; cabv[q] = cab;
            }
        }
    }
}

__device__ __forceinline__ void indexer_phase(const Params& p, unsigned char* lds) {
    unsigned char* ws = p.ws;
    const u16* QI = (const u16*)(ws + WS_QI);
    const u16* KI = (const u16*)(ws + WS_KI);
    const float* WI = (const float*)(ws + WS_WI);
    u16* SEL = (u16*)(ws + WS_SEL);
    unsigned* hist = reinterpret_cast<unsigned*>(lds);
    float* candv = reinterpret_cast<float*>(lds);
    int* candi = reinterpret_cast<int*>(lds + 32768);
    int* misc = reinterpret_cast<int*>(lds + 131072);
    int* nsel = misc; int* ncand = misc + 32; int* tbv = misc + 64; int* cabv = misc + 96; int* nlog = misc + 128;
    const int tid = tid_fresh(), lane = tid & 63, wave = tid >> 6;
    const int l16 = lane & 15, kq = lane >> 4;
    const int grp = wave >> 2, wg = wave & 3;
    const int ql = grp * 16 + l16;
    const int G = gridDim.x, bid = blockIdx.x;
    constexpr int NT = NQ / 32;
    IdxCtx cx;
    cx.l16 = l16; cx.kq = kq; cx.ql = ql; cx.wg = wg; cx.wave = __builtin_amdgcn_readfirstlane(wave);
    cx.hist = hist; cx.nsel = nsel; cx.ncand = ncand; cx.candv = candv; cx.candi = candi; cx.nlog = nlog;
    unsigned long long* const logbase = reinterpret_cast<unsigned long long*>(ws + WS_A0) + (size_t)bid * 32 * LOGCAP;
    cx.logq = logbase + (size_t)ql * LOGCAP;
    cx.ring = lds + 65536;
    cx.ring_lds = __builtin_amdgcn_readfirstlane((unsigned)(unsigned long long)(__attribute__((address_space(3))) unsigned char*)lds + 65536u);
    cx.dma_voff = (unsigned)((lane >> 3) * 128 + (((lane & 7) ^ (lane >> 3)) * 16));
    for (int it = 0; it * G < NT; ++it) {
        const int r = it * G + ((it & 1) ? (G - 1 - bid) : bid);
        if (r >= NT) continue;
        const int b = r & 1, idx = (NT / 2 - 1) - (r >> 1);
        const int p0 = NMETA + 32 * idx;
        const size_t qn0 = (size_t)b * SEQ + 32 * idx;
        const int nch = idx + 2;
        cx.KIb = KI + (size_t)b * LTOK * 64; cx.pos = p0 + ql;
        cx.selq = SEL + (qn0 + ql) * 256;
        bf16x8 bq[8][2];
        float w[8];
        {
            const u16* qp = QI + (qn0 + ql) * 512 + kq * 8;
#pragma unroll
            for (int h = 0; h < 8; ++h)
#pragma unroll
            for (int ks = 0; ks < 2; ++ks) bq[h][ks] = *reinterpret_cast<const bf16x8*>(qp + h * 64 + ks * 32);
#pragma unroll
            for (int h = 0; h < 8; ++h) w[h] = 0.5f * WI[(qn0 + ql) * 8 + h];
        }
        bf16x8 bl[2][2];
#pragma unroll
        for (int ks = 0; ks < 2; ++ks) {
            float qc[8];
#pragma unroll
            for (int j = 0; j < 8; ++j) qc[j] = 0.f;
#pragma unroll
            for (int h = 0; h < 8; ++h) {
                union { bf16x8 v; unsigned u[4]; } cv; cv.v = bq[h][ks];
#pragma unroll
                for (int j = 0; j < 4; ++j) { qc[2 * j] = fmaf(w[h], bflo(cv.u[j]), qc[2 * j]); qc[2 * j + 1] = fmaf(w[h], bfhi(cv.u[j]), qc[2 * j + 1]); }
            }
            union { bf16x8 v; unsigned u[4]; } hi, lo;
#pragma unroll
            for (int j = 0; j < 4; ++j) {
                const unsigned hp = pack2(qc[2 * j], qc[2 * j + 1]);
                hi.u[j] = hp;
                lo.u[j] = pack2(qc[2 * j] - bflo(hp), qc[2 * j + 1] - bfhi(hp));
            }
            bl[0][ks] = hi.v; bl[1][ks] = lo.v;
        }
        {
            uint4 z = {0u, 0u, 0u, 0u};
            for (int i = tid; i < 65536 / 16; i += NTHREADS) reinterpret_cast<uint4*>(lds)[i] = z;
            if (tid < 256) misc[tid] = 0;
        }
        __syncthreads();
        float thr = -INFINITY;
        constexpr int LOG0 = 64;
        idx_chunks<1, false>(cx, 0, min(nch, LOG0), bq, bl, w, thr, 0);
        if (nch > LOG0) {
            idx_threshold_scan(hist, tbv, cabv, wave, lane);
            __syncthreads();
            thr = bin_lower_edge(tbv[ql]);
            idx_chunks<1, true>(cx, LOG0, min(nch, 128), bq, bl, w, thr, 0);
            if (nch > 128) {
                idx_threshold_scan(hist, tbv, cabv, wave, lane);
                __syncthreads();
                thr = bin_lower_edge(tbv[ql]);
                idx_chunks<1, true>(cx, 128, min(nch, 256), bq, bl, w, thr, 0);
                if (nch > 256) {
                    idx_threshold_scan(hist, tbv, cabv, wave, lane);
                    __syncthreads();
                    thr = bin_lower_edge(tbv[ql]);
                    idx_chunks<1, true>(cx, 256, nch, bq, bl, w, thr, 0);
                }
            }
        }
        idx_threshold_scan(hist, tbv, cabv, wave, lane);
        __syncthreads();
        const int mytb = tbv[ql];
        const bool use_log = (nch > LOG0) && (__syncthreads_or(nlog[ql] > LOGCAP) == 0);
        idx_chunks<2, false>(cx, 0, use_log ? LOG0 : nch, bq, bl, w, bin_lower_edge(mytb), mytb);
        if (use_log) {
#pragma unroll 1
            for (int qq = 0; qq < 4; ++qq) {
                const int q = wave * 4 + qq;
                const int tb = tbv[q];
                const int n = nlog[q];
                const unsigned long long* lq = logbase + (size_t)q * LOGCAP;
                u16* so = SEL + (qn0 + q) * 256;
#pragma unroll 1
                for (int i = lane; i < n; i += 64) {
                    const unsigned long long ent = __hip_atomic_load(lq + i, __ATOMIC_RELAXED, __HIP_MEMORY_SCOPE_AGENT);
                    const float v = __uint_as_float((unsigned)ent);
                    const int ks = (int)(ent >> 32);
                    const int bin = score_bin(v);
                    if (bin > tb) {
                        const int slot2 = atomicAdd(&nsel[q], 1);
                        if (slot2 < 256) so[slot2] = (u16)ks;
                    } else if (bin == tb) {
                        const int cidx = atomicAdd(&ncand[q], 1);
                        if (cidx < 256) { candv[q * 256 + cidx] = v; candi[q * 256 + cidx] = ks; }
                    }
                }
            }
            __syncthreads();
        }
#pragma unroll 1
        for (int qq = 0; qq < 4; ++qq) {
            const int q = wave * 4 + qq;
            const int tb = tbv[q], cab = cabv[q];
            const int n = min(ncand[q], 256);
            const int need = (tb < 0) ? 0 : (256 - cab);
            u16* so = SEL + (qn0 + q) * 256;
            if (tb >= 0) {
#pragma unroll 1
                for (int i = lane; i < n; i += 64) {
                    const float vi = candv[q * 256 + i];
                    const int si = candi[q * 256 + i];
                    int rank = 0;
#pragma unroll 2
                    for (int jn = 0; jn < n; ++jn) {
                        const float vj = candv[q * 256 + jn];
                        const int sj = candi[q * 256 + jn];
                        rank += (vj > vi || (vj == vi && sj < si)) ? 1 : 0;
                    }
                    if (rank < need) so[cab + rank] = (u16)si;
                }
            }
            const int total = (tb < 0) ? min(nsel[q], 256) : min(256, cab + min(need, n));
            for (int s2 = total + lane; s2 < 256; s2 += 64) so[s2] = (u16)0xFFFFu;
        }
        __syncthreads();
    }
}

__device__ __forceinline__ void attn_conv_phase(const Params& p, unsigned char* lds, const bool do_attn, const bool do_conv) {
    unsigned char* ws = p.ws;
    const u16* QO = (const u16*)(ws + WS_Q);
    u16* OB = (u16*)(ws + WS_A0);
    const unsigned char* K8 = ws + WS_K8;
    const unsigned char* V8 = ws + WS_V8;
    const u16* SEL = (const u16*)(ws + WS_SEL);
    const int tid = tid_fresh(), lane = tid & 63, wave = tid >> 6;
    const int G = gridDim.x, bid = blockIdx.x;
    float* lg = reinterpret_cast<float*>(lds) + wave * 256;
    u16* selb = reinterpret_cast<u16*>(lds + 8192) + wave * 256;
    const int grp = lane >> 3, sub = lane & 7, quad = lane >> 4, n16 = lane & 15;
    const bool local = (G % 8) == 0;
    const int head_fixed = bid & 7;
    const int nitems = local ? NQ : NQ * 8;
    const int start = local ? ((bid >> 3) * 8 + wave) : (bid * 8 + wave);
    const int step = local ? (G >> 3) * 8 : G * 8;
    uint4 qnx[2][2] = {};
    uint2 svnx = {0u, 0u};
    if (do_attn && start < nitems) {
        const int qn_ = local ? start : (start >> 3), head_ = local ? head_fixed : (start & 7);
        const u16* qrow_ = QO + (size_t)qn_ * D + head_ * 128 + quad * 16;
#pragma unroll
        for (int hsel = 0; hsel < 2; ++hsel) { const uint4* qp_ = reinterpret_cast<const uint4*>(qrow_ + hsel * 64); qnx[hsel][0] = qp_[0]; qnx[hsel][1] = qp_[1]; }
        svnx = *reinterpret_cast<const uint2*>(SEL + (size_t)qn_ * 256 + lane * 4);
    }
    if (do_attn)
    for (int item = start; item < nitems; item += step) {
        const int qn = local ? item : (item >> 3);
        const int head = local ? head_fixed : (item & 7);
        const int b = qn >> 14;
        uint4 qcur[2][2];
#pragma unroll
        for (int hsel = 0; hsel < 2; ++hsel) { qcur[hsel][0] = qnx[hsel][0]; qcur[hsel][1] = qnx[hsel][1]; }
        *reinterpret_cast<uint2*>(selb + lane * 4) = svnx;
        if (item + step < nitems) {
            const int it2 = item + step;
            const int qn_ = local ? it2 : (it2 >> 3), head_ = local ? head_fixed : (it2 & 7);
            const u16* qrow_ = QO + (size_t)qn_ * D + head_ * 128 + quad * 16;
#pragma unroll
            for (int hsel = 0; hsel < 2; ++hsel) { const uint4* qp_ = reinterpret_cast<const uint4*>(qrow_ + hsel * 64); qnx[hsel][0] = qp_[0]; qnx[hsel][1] = qp_[1]; }
            svnx = *reinterpret_cast<const uint2*>(SEL + (size_t)qn_ * 256 + lane * 4);
        }
        long qa_hi[4], qa_lo[4];
        {
#pragma unroll
            for (int hsel = 0; hsel < 2; ++hsel) {
                const uint4 a = qcur[hsel][0], c = qcur[hsel][1];
                const unsigned uu[8] = {a.x, a.y, a.z, a.w, c.x, c.y, c.z, c.w};
#pragma unroll
                for (int s2 = 0; s2 < 2; ++s2) {
                    float f[8];
#pragma unroll
                    for (int i = 0; i < 4; ++i) { f[2 * i] = bflo(uu[s2 * 4 + i]); f[2 * i + 1] = bfhi(uu[s2 * 4 + i]); }
                    int h0 = __builtin_amdgcn_cvt_pk_fp8_f32(f[0], f[1], 0, false);
                    h0 = __builtin_amdgcn_cvt_pk_fp8_f32(f[2], f[3], h0, true);
                    int h1 = __builtin_amdgcn_cvt_pk_fp8_f32(f[4], f[5], 0, false);
                    h1 = __builtin_amdgcn_cvt_pk_fp8_f32(f[6], f[7], h1, true);
                    const f32x2 b0 = __builtin_amdgcn_cvt_pk_f32_fp8(h0, false), b1 = __builtin_amdgcn_cvt_pk_f32_fp8(h0, true);
                    const f32x2 b2 = __builtin_amdgcn_cvt_pk_f32_fp8(h1, false), b3 = __builtin_amdgcn_cvt_pk_f32_fp8(h1, true);
                    int l0 = __builtin_amdgcn_cvt_pk_fp8_f32((f[0] - b0.x) * 16.f, (f[1] - b0.y) * 16.f, 0, false);
                    l0 = __builtin_amdgcn_cvt_pk_fp8_f32((f[2] - b1.x) * 16.f, (f[3] - b1.y) * 16.f, l0, true);
                    int l1 = __builtin_amdgcn_cvt_pk_fp8_f32((f[4] - b2.x) * 16.f, (f[5] - b2.y) * 16.f, 0, false);
                    l1 = __builtin_amdgcn_cvt_pk_fp8_f32((f[6] - b3.x) * 16.f, (f[7] - b3.y) * 16.f, l1, true);
                    qa_hi[hsel * 2 + s2] = (long)(((unsigned long long)(unsigned)h1 << 32) | (unsigned)h0);
                    qa_lo[hsel * 2 + s2] = (long)(((unsigned long long)(unsigned)l1 << 32) | (unsigned)l0);
                }
            }
        }
        const size_t kslab = (size_t)(b * 8 + head) * LTOK * 128 + quad * 16;
        uint4 kbuf[2][4][2];
        bool kok[2][4];
#define LOADK(BUF, BT) do { _Pragma("unroll") for (int g = 0; g < 4; ++g) { \
            const int idx_ = selb[((BT) * 4 + g) * 16 + n16]; kok[BUF][g] = idx_ != 0xFFFF; \
            const unsigned char* kp_ = K8 + kslab + (size_t)(kok[BUF][g] ? idx_ : 0) * 128; \
            kbuf[BUF][g][0] = *reinterpret_cast<const uint4*>(kp_); kbuf[BUF][g][1] = *reinterpret_cast<const uint4*>(kp_ + 64); } } while (0)
        LOADK(0, 0);
#pragma unroll
        for (int bt = 0; bt < 4; ++bt) {
            if (bt < 3) LOADK((bt + 1) & 1, bt + 1);
#pragma unroll
            for (int g = 0; g < 4; ++g) {
                const uint4 k0 = kbuf[bt & 1][g][0], k1 = kbuf[bt & 1][g][1];
                const long kb[4] = {(long)(((unsigned long long)k0.y << 32) | k0.x), (long)(((unsigned long long)k0.w << 32) | k0.z),
                                    (long)(((unsigned long long)k1.y << 32) | k1.x), (long)(((unsigned long long)k1.w << 32) | k1.z)};
                f32x4 ah = {0.f, 0.f, 0.f, 0.f}, al = {0.f, 0.f, 0.f, 0.f};
#pragma unroll
                for (int s4 = 0; s4 < 4; ++s4) {
                    ah = __builtin_amdgcn_mfma_f32_16x16x32_fp8_fp8(qa_hi[s4], kb[s4], ah, 0, 0, 0);
                    al = __builtin_amdgcn_mfma_f32_16x16x32_fp8_fp8(qa_lo[s4], kb[s4], al, 0, 0, 0);
                }
                if (lane < 16) lg[(bt * 4 + g) * 16 + lane] = kok[bt & 1][g] ? (ah[0] + al[0] * 0.0625f) * ATT_SCALE : -INFINITY;
            }
        }
#undef LOADK
        const size_t slab = (size_t)(b * 8 + head) * LTOK * 128 + sub * 16;
        uint4 vbuf[2][8];
#define LOADV(BUF, BT) do { _Pragma("unroll") for (int i = 0; i < 8; ++i) { \
            const int idx_ = selb[((BT) * 8 + i) * 8 + grp]; \
            vbuf[BUF][i] = *reinterpret_cast<const uint4*>(V8 + slab + (size_t)(idx_ != 0xFFFF ? idx_ : 0) * 128); } } while (0)
        LOADV(0, 0);
        {
            float4 l4 = *reinterpret_cast<const float4*>(lg + lane * 4);
            float mx = fmaxf(fmaxf(l4.x, l4.y), fmaxf(l4.z, l4.w));
#pragma unroll
            for (int o = 32; o > 0; o >>= 1) mx = fmaxf(mx, __shfl_xor(mx, o));
            l4.x = __expf(l4.x - mx); l4.y = __expf(l4.y - mx); l4.z = __expf(l4.z - mx); l4.w = __expf(l4.w - mx);
            float sm = wave_sum(l4.x + l4.y + l4.z + l4.w);
            const float inv = 1.f / sm;
            l4.x *= inv; l4.y *= inv; l4.z *= inv; l4.w *= inv;
            *reinterpret_cast<float4*>(lg + lane * 4) = l4;
        }
        f32x2 o2[8];
#pragma unroll
        for (int i = 0; i < 8; ++i) { o2[i].x = 0.f; o2[i].y = 0.f; }
#pragma unroll
        for (int bt = 0; bt < 4; ++bt) {
            if (bt < 3) LOADV((bt + 1) & 1, bt + 1);
#pragma unroll
            for (int i = 0; i < 8; ++i) {
                const float pj = lg[(bt * 8 + i) * 8 + grp];
                const f32x2 pj2 = {pj, pj};
                const uint4 vv = vbuf[bt & 1][i];
                const unsigned uu[4] = {vv.x, vv.y, vv.z, vv.w};
#pragma unroll
                for (int e = 0; e < 4; ++e) {
                    const f32x2 lo = __builtin_amdgcn_cvt_pk_f32_fp8((int)uu[e], false);
                    const f32x2 hi = __builtin_amdgcn_cvt_pk_f32_fp8((int)uu[e], true);
                    o2[2 * e] = __builtin_elementwise_fma(lo, pj2, o2[2 * e]);
                    o2[2 * e + 1] = __builtin_elementwise_fma(hi, pj2, o2[2 * e + 1]);
                }
            }
        }
#undef LOADV
        float o[16];
#pragma unroll
        for (int i = 0; i < 8; ++i) { o[2 * i] = o2[i].x; o[2 * i + 1] = o2[i].y; }
#pragma unroll
        for (int i = 0; i < 16; ++i) { o[i] += __shfl_xor(o[i], 8); o[i] += __shfl_xor(o[i], 16); o[i] += __shfl_xor(o[i], 32); }
        if (grp == 0) {
            uint4 a, c;
            a.x = pack2(o[0], o[1]); a.y = pack2(o[2], o[3]); a.z = pack2(o[4], o[5]); a.w = pack2(o[6], o[7]);
            c.x = pack2(o[8], o[9]); c.y = pack2(o[10], o[11]); c.z = pack2(o[12], o[13]); c.w = pack2(o[14], o[15]);
            uint4* op = reinterpret_cast<uint4*>(OB + (size_t)qn * D + head * 128 + sub * 16);
            op[0] = a; op[1] = c;
        }
    }
    if (do_conv) {
        const u16* P = (const u16*)(ws + WS_P);
        u16* CB = (u16*)(ws + WS_CB);
        u16* U = CB;
        const int total = NQ * (D / 8);
        for (int e = bid * NTHREADS + tid; e < total; e += G * NTHREADS) {
            const int qn = e >> 7, c8 = (e & 127) * 8;
            const int b = qn >> 14;
            const size_t tok = (size_t)b * LTOK + NMETA + (qn & (SEQ - 1));
            const uint4 p0 = *reinterpret_cast<const uint4*>(P + (tok - 2) * D + c8);
            const uint4 p1 = *reinterpret_cast<const uint4*>(P + (tok - 1) * D + c8);
            const uint4 p2 = *reinterpret_cast<const uint4*>(P + tok * D + c8);
            const uint4 cb = *reinterpret_cast<const uint4*>(CB + (size_t)qn * D + c8);
            const unsigned a0[4] = {p0.x, p0.y, p0.z, p0.w}, a1[4] = {p1.x, p1.y, p1.z, p1.w}, a2[4] = {p2.x, p2.y, p2.z, p2.w},
                           ab[4] = {cb.x, cb.y, cb.z, cb.w};
            float w0[8], w1[8], w2[8];
#pragma unroll
            for (int i = 0; i < 8; ++i) { w0[i] = p.conv_w[c8 + i]; w1[i] = p.conv_w[D + c8 + i]; w2[i] = p.conv_w[2 * D + c8 + i]; }
            unsigned o[4];
#pragma unroll
            for (int i = 0; i < 4; ++i) {
                float lo = bflo(ab[i]) * (w0[2 * i] * bflo(a0[i]) + w1[2 * i] * bflo(a1[i]) + w2[2 * i] * bflo(a2[i]));
                float hi = bfhi(ab[i]) * (w0[2 * i + 1] * bfhi(a0[i]) + w1[2 * i + 1] * bfhi(a1[i]) + w2[2 * i + 1] * bfhi(a2[i]));
                o[i] = pack2(lo, hi);
            }
            uint4 ov = {o[0], o[1], o[2], o[3]};
            *reinterpret_cast<uint4*>(U + (size_t)qn * D + c8) = ov;
        }
    }
}

__device__ __forceinline__ void final_norm_phase(const Params& p) {
    const float* ss2 = (const float*)(p.ws + WS_SS2);
    const int ftid = tid_fresh();
    const int lane = ftid & 63, wave = ftid >> 6;
    for (int r = blockIdx.x * 8 + wave; r < NQ; r += gridDim.x * 8) {
        const float rstd = rsqrtf(ss2[r] * (1.f / D) + EPS);
        float* row = p.out + (size_t)r * D;
#pragma unroll
        for (int i = 0; i < 4; ++i) {
            float4 v = *reinterpret_cast<float4*>(row + i * 256 + lane * 4);
            const float4 g = *reinterpret_cast<const float4*>(p.g_final + i * 256 + lane * 4);
            v.x *= rstd * g.x; v.y *= rstd * g.y; v.z *= rstd * g.z; v.w *= rstd * g.w;
            *reinterpret_cast<float4*>(row + i * 256 + lane * 4) = v;
        }
    }
}

__device__ __forceinline__ void grid_bar(unsigned* ctr, unsigned& nbar) {
    __syncthreads();
    ++nbar;
    if (threadIdx.x == 0) {
        __builtin_amdgcn_fence(__ATOMIC_RELEASE, "agent");
        asm volatile("s_waitcnt vmcnt(0)" ::: "memory");
        __hip_atomic_fetch_add(ctr, 1u, __ATOMIC_RELAXED, __HIP_MEMORY_SCOPE_AGENT);
        const unsigned target = nbar * gridDim.x;
        while (__hip_atomic_load(ctr, __ATOMIC_RELAXED, __HIP_MEMORY_SCOPE_AGENT) < target) __builtin_amdgcn_s_sleep(1);
        __builtin_amdgcn_fence(__ATOMIC_ACQUIRE, "agent");
        asm volatile("s_waitcnt vmcnt(0)" ::: "memory");
    }
    __syncthreads();
}

__global__ void __launch_bounds__(NTHREADS, 2) fwd_megakernel(Params p) {
    extern __shared__ __attribute__((aligned(16))) unsigned char lds[];
    cg::grid_group grid = cg::this_grid();
    unsigned char* ws = p.ws;
    const int lo = p.ph_lo, hi = p.ph_hi;
    const EpiArgs ea{ws, p.x, p.out};
#define IN(k) (lo <= (k) && (k) < hi)
    unsigned nbar = 0;
    unsigned* bar_ctr = (unsigned*)(ws + WS_CTL);
#define SEAM(k) do { if (IN(k) && IN((k) + 1)) { if ((k) == 0) grid.sync(); else grid_bar(bar_ctr, nbar); } } while (0)
    if (IN(0)) phase_prep(p, lds);
    SEAM(0);
    if (IN(1)) gemm_phase<EPI_PROJ, TOKP, NPROJ, D>((const u16*)(ws + WS_A0), (const u16*)(ws + WS_WIN), ea, lds);
    SEAM(1);
    if (IN(2)) indexer_phase(p, lds);
    SEAM(2);
    if (IN(3)) attn_conv_phase(p, lds, true, true);
    SEAM(3);
    if (IN(5)) gemm_phase<EPI_MIX, NQ, D, D>((const u16*)(ws + WS_A0), (const u16*)(ws + WS_WA), ea, lds, (const u16*)(ws + WS_CB), (const u16*)(ws + WS_WC));
    SEAM(5);
    if (IN(6)) gemm_phase<EPI_H1, NQ, D, D>((const u16*)(ws + WS_P), (const u16*)(ws + WS_WO), ea, lds);
    SEAM(6);
    if (IN(7)) gemm_phase<EPI_GU, NQ, 2 * DFF, D>((const u16*)(ws + WS_CB), (const u16*)(ws + WS_WGU), ea, lds);
    SEAM(7);
    if (IN(8)) gemm_phase<EPI_DOWN, NQ, D, DFF>((const u16*)(ws + WS_ACT), (const u16*)(ws + WS_WD), ea, lds);
    SEAM(8);
    if (IN(9)) final_norm_phase(p);
#undef IN
#undef SEAM
}

extern "C" void kernel_launch(void* const* d_in, const int* in_sizes, int n_in, void* d_out, int out_size, void* d_ws,
                              size_t ws_size, hipStream_t stream) {
    static int grid_blocks = 0;
    if (grid_blocks == 0) {
        if (n_in != 13 || out_size != NQ * D || ws_size < WS_END) {
            fprintf(stderr, "kernel_launch: unexpected shapes (n_in %d out %d ws %zu need %zu)\n", n_in, out_size, ws_size, (size_t)WS_END);
            grid_blocks = -1; return;
        }
        int dev = 0, cus = 0, per_cu = 0;
        hipGetDevice(&dev);
        hipDeviceGetAttribute(&cus, hipDeviceAttributeMultiprocessorCount, dev);
        if (hipFuncSetAttribute((const void*)fwd_megakernel, hipFuncAttributeMaxDynamicSharedMemorySize, LDS_BYTES) != hipSuccess) {
            fprintf(stderr, "kernel_launch: hipFuncSetAttribute failed\n"); grid_blocks = -1; return;
        }
        hipOccupancyMaxActiveBlocksPerMultiprocessor(&per_cu, (const void*)fwd_megakernel, NTHREADS, LDS_BYTES);
        if (per_cu < 1) { fprintf(stderr, "kernel_launch: occupancy query says %d blocks/CU\n", per_cu); grid_blocks = -1; return; }
        grid_blocks = cus < 256 ? cus : 256;
    }
    if (grid_blocks < 0) return;
    if (hipMemsetAsync((unsigned char*)d_ws + WS_CTL, 0, 256, stream) != hipSuccess) { fprintf(stderr, "kernel_launch: memset failed\n"); return; }
    Params p{};
    p.x = (const float*)d_in[0]; p.meta = (const float*)d_in[1]; p.g_mix = (const float*)d_in[2]; p.w_in = (const float*)d_in[3];
    p.w_attn_out = (const float*)d_in[4]; p.conv_w = (const float*)d_in[5]; p.w_conv_out = (const float*)d_in[6];
    p.w_out = (const float*)d_in[7]; p.g_ffn = (const float*)d_in[8]; p.w_gate = (const float*)d_in[9]; p.w_up = (const float*)d_in[10];
    p.w_down = (const float*)d_in[11]; p.g_final = (const float*)d_in[12];
    p.out = (float*)d_out; p.ws = (unsigned char*)d_ws; p.ph_lo = 0; p.ph_hi = 10; p.probe = PROBE_MODE; p.pad = 0;
    void* args[] = {&p};
    hipError_t e = hipLaunchCooperativeKernel((const void*)fwd_megakernel, dim3(grid_blocks), dim3(NTHREADS), args, LDS_BYTES, stream);
    if (e != hipSuccess) fprintf(stderr, "cooperative launch failed: %s (grid %d)\n", hipGetErrorString(e), grid_blocks);
}
```

```cpp
#include <hip/hip_runtime.h>
#include <hip/hip_bf16.h>
#include <hip/hip_cooperative_groups.h>
#include <cstdio>
namespace cg = cooperative_groups;

typedef unsigned short u16;
using bf16x8 = __attribute__((ext_vector_type(8))) __bf16;
using f32x4  = __attribute__((ext_vector_type(4))) float;
using f32x16 = __attribute__((ext_vector_type(16))) float;

constexpr int D = 1024, SEQ = 16384, NMETA = 16, LTOK = SEQ + NMETA;
constexpr int NB = 2, TOK = NB * LTOK;
constexpr int TOKP = 33024;
constexpr int NQ = NB * SEQ;
constexpr int DFF = 2816, PROJW = 8776, NPROJ = 8960;
constexpr int OFF_Q = 0, OFF_K = 1024, OFF_V = 2048, OFF_QI = 3072, OFF_KI = 3584, OFF_WI = 3648,
              OFF_CU = 3656, OFF_CB = 4680, OFF_CC = 5704, OFF_GA = 6728, OFF_GB = 7752;
constexpr float EPS = 1e-6f;
constexpr float IDX_SCALE = 0.04419417382415922f;
constexpr float ATT_SCALE = 0.08838834764831845f;
#ifndef PROBE_MODE
#define PROBE_MODE 0
#endif
constexpr int NTHREADS = 512;
constexpr int LDS_BYTES = 131072 + 4096;

constexpr size_t al256(size_t x) { return (x + 255) & ~(size_t)255; }
constexpr size_t WS_WIN  = 0;
constexpr size_t WS_WA   = WS_WIN + al256((size_t)NPROJ * D * 2);
constexpr size_t WS_WC   = WS_WA + al256((size_t)D * D * 2);
constexpr size_t WS_WO   = WS_WC + al256((size_t)D * D * 2);
constexpr size_t WS_WGU  = WS_WO + al256((size_t)D * D * 2);
constexpr size_t WS_WD   = WS_WGU + al256((size_t)2 * DFF * D * 2);
constexpr size_t WS_A0   = WS_WD + al256((size_t)D * DFF * 2);
constexpr size_t WS_Q    = WS_A0 + al256((size_t)TOKP * D * 2);
constexpr size_t WS_K    = WS_Q + al256((size_t)NQ * D * 2);
constexpr size_t WS_V    = WS_K + al256((size_t)TOK * D * 2);
constexpr size_t WS_P    = WS_V + al256((size_t)TOK * D * 2);
constexpr size_t WS_CB   = WS_P + al256((size_t)TOK * D * 2);
constexpr size_t WS_QI   = WS_CB + al256((size_t)NQ * D * 2);
constexpr size_t WS_KI   = WS_QI + al256((size_t)NQ * 512 * 2);
constexpr size_t WS_WI   = WS_KI + al256((size_t)TOKP * 64 * 2);
constexpr size_t WS_SEL  = WS_WI + al256((size_t)NQ * 8 * 4);
constexpr size_t WS_SS1  = WS_SEL + al256((size_t)NQ * 256 * 2);
constexpr size_t WS_SS2  = WS_SS1 + al256((size_t)NQ * 4);
constexpr size_t WS_CTL  = WS_SS2 + al256((size_t)NQ * 4);
constexpr size_t WS_END  = WS_CTL + 256;
constexpr size_t WS_K8   = WS_K;
constexpr size_t WS_V8   = WS_K + al256((size_t)TOK * D);
constexpr size_t WS_ACT  = WS_A0;
static_assert((size_t)NQ * DFF * 2 <= WS_V - WS_A0, "ACT overlay");
static_assert((size_t)NQ * D * 4 <= WS_P - WS_K, "T1 overlay");
static_assert(WS_END <= (size_t)536870912, "workspace");

struct Params {
    const float *x, *meta, *g_mix, *w_in, *w_attn_out, *conv_w, *w_conv_out, *w_out, *g_ffn, *w_gate, *w_up, *w_down, *g_final;
    float* out;
    unsigned char* ws;
    int ph_lo, ph_hi, probe, pad;
};

typedef __bf16 bf16x2_t __attribute__((ext_vector_type(2)));
typedef float f32x2_t __attribute__((ext_vector_type(2)));
__device__ __forceinline__ u16 f2bf(float f) { return __builtin_bit_cast(u16, (__bf16)f); }
__device__ __forceinline__ unsigned pack2(float a, float b) { const f32x2_t v = {a, b}; return __builtin_bit_cast(unsigned, __builtin_convertvector(v, bf16x2_t)); }
__device__ __forceinline__ float bflo(unsigned u) { return __uint_as_float(u << 16); }
__device__ __forceinline__ float bfhi(unsigned u) { return __uint_as_float(u & 0xFFFF0000u); }
__device__ __forceinline__ float sigmoidf_(float x) { return 1.f / (1.f + __expf(-x)); }
__device__ __forceinline__ float wave_sum(float v) {
#pragma unroll
    for (int o = 32; o > 0; o >>= 1) v += __shfl_xor(v, o);
    return v;
}

__device__ __forceinline__ int tid_fresh() { int t = threadIdx.x; asm volatile("" : "+v"(t)); return t; }

__device__ __forceinline__ void transpose_tile(const float* __restrict__ src, int srcN, int Kdim, u16* __restrict__ dst, int n0, int srccol0,
                               int nvalid, int k0, const float* __restrict__ kscale, float* tl, const int tid) {
    {
        const int tn = tid & 63, tk = tid >> 6;
        float v[16];
#pragma unroll
        for (int i = 0; i < 16; ++i) {
            const int k = tk + i * 8;
            v[i] = 0.f;
            if (tn < nvalid) v[i] = src[(size_t)(k0 + k) * srcN + srccol0 + tn];
        }
        if (kscale) {
#pragma unroll
            for (int i = 0; i < 16; ++i) v[i] *= kscale[k0 + tk + i * 8];
        }
#pragma unroll
        for (int i = 0; i < 16; ++i) tl[(tk + i * 8) * 65 + tn] = v[i];
    }
    __syncthreads();
    {
        const int n = tid >> 3, kk = (tid & 7) * 16;
        float v[16];
#pragma unroll
        for (int i = 0; i < 16; ++i) v[i] = tl[(kk + i) * 65 + n];
        uint4 o0, o1;
        o0.x = pack2(v[0], v[1]); o0.y = pack2(v[2], v[3]); o0.z = pack2(v[4], v[5]); o0.w = pack2(v[6], v[7]);
        o1.x = pack2(v[8], v[9]); o1.y = pack2(v[10], v[11]); o1.z = pack2(v[12], v[13]); o1.w = pack2(v[14], v[15]);
        uint4* dp = reinterpret_cast<uint4*>(dst + (size_t)(n0 + n) * Kdim + k0 + kk);
        dp[0] = o0; dp[1] = o1;
    }
    __syncthreads();
}

__device__ __forceinline__ void phase_prep(const Params& p, unsigned char* lds) {
    float* tl = reinterpret_cast<float*>(lds);
    unsigned char* ws = p.ws;
    const int tid = tid_fresh();
    const int G = gridDim.x, bid = blockIdx.x;
    constexpr int T_IN = (NPROJ / 64) * 8;
    constexpr int T_SQ = 16 * 8;
    constexpr int T_GU = (2 * DFF / 64) * 8;
    constexpr int T_DN = 16 * (DFF / 128);
    constexpr int T_ALL = T_IN + 3 * T_SQ + T_GU + T_DN;
    for (int t = bid; t < T_ALL; t += G) {
        if (t < T_IN) {
            int g64 = t >> 3, kt = t & 7;
            int n0 = g64 * 64, pn = n0 >> 8, lc = n0 & 255;
            int sc0 = 0, nv = 64;
            if (pn < 12) sc0 = n0;
            else if (pn < 20) { int c0 = (pn - 12) * 128; sc0 = (lc < 128) ? (OFF_CU + c0 + lc) : (OFF_CC + c0 + lc - 128); }
            else if (pn < 24) sc0 = OFF_CB + (pn - 20) * 256 + lc;
            else if (pn < 28) sc0 = OFF_GA + (pn - 24) * 256 + lc;
            else if (pn < 32) sc0 = OFF_GB + (pn - 28) * 256 + lc;
            else if (pn < 34) sc0 = OFF_QI + (pn - 32) * 256 + lc;
            else { if (lc == 0) { sc0 = OFF_KI; nv = 64; } else if (lc == 64) { sc0 = OFF_WI; nv = 8; } else { sc0 = 0; nv = 0; } }
            transpose_tile(p.w_in, PROJW, D, (u16*)(ws + WS_WIN), n0, sc0, nv, kt * 128, nullptr, tl, tid);
        } else if (t < T_IN + 3 * T_SQ) {
            int u = t - T_IN, which = u / T_SQ, v = u % T_SQ;
            const float* src = which == 0 ? p.w_attn_out : (which == 1 ? p.w_conv_out : p.w_out);
            u16* dst = (u16*)(ws + (which == 0 ? WS_WA : (which == 1 ? WS_WC : WS_WO)));
            int n0 = (v >> 3) * 64, k0 = (v & 7) * 128;
            transpose_tile(src, D, D, dst, n0, n0, 64, k0, nullptr, tl, tid);
        } else if (t < T_IN + 3 * T_SQ + T_GU) {
            int u = t - T_IN - 3 * T_SQ;
            int g64 = u >> 3, kt = u & 7;
            int n0 = g64 * 64, pn = n0 >> 8, lc = n0 & 255;
            const float* src = (lc < 128) ? p.w_gate : p.w_up;
            int sc0 = pn * 128 + (lc & 127);
            transpose_tile(src, DFF, D, (u16*)(ws + WS_WGU), n0, sc0, 64, kt * 128, p.g_ffn, tl, tid);
        } else {
            int u = t - T_IN - 3 * T_SQ - T_GU;
            int nt = u / (DFF / 128), kt = u % (DFF / 128);
            transpose_tile(p.w_down, D, DFF, (u16*)(ws + WS_WD), nt * 64, nt * 64, 64, kt * 128, nullptr, tl, tid);
        }
    }
    const int lane = tid & 63, wave = tid >> 6;
    u16* A0 = (u16*)(ws + WS_A0);
    for (int r = bid * 8 + wave; r < TOKP; r += G * 8) {
        uint2 o[4];
        if (r < TOK) {
            int b = r / LTOK, pos = r - b * LTOK;
            const float* src = (pos < NMETA) ? (p.meta + (size_t)pos * D) : (p.x + ((size_t)b * SEQ + (pos - NMETA)) * D);
            float4 v[4];
            float ss = 0.f;
#pragma unroll
            for (int i = 0; i < 4; ++i) {
                v[i] = *reinterpret_cast<const float4*>(src + i * 256 + lane * 4);
                ss += v[i].x * v[i].x + v[i].y * v[i].y + v[i].z * v[i].z + v[i].w * v[i].w;
            }
            ss = wave_sum(ss);
            float rstd = rsqrtf(ss * (1.f / D) + EPS);
#pragma unroll
            for (int i = 0; i < 4; ++i) {
                float4 g = *reinterpret_cast<const float4*>(p.g_mix + i * 256 + lane * 4);
                o[i].x = pack2(v[i].x * rstd * g.x, v[i].y * rstd * g.y);
                o[i].y = pack2(v[i].z * rstd * g.z, v[i].w * rstd * g.w);
            }
        } else {
#pragma unroll
            for (int i = 0; i < 4; ++i) { o[i].x = 0; o[i].y = 0; }
        }
#pragma unroll
        for (int i = 0; i < 4; ++i) *reinterpret_cast<uint2*>(A0 + (size_t)r * D + i * 256 + lane * 4) = o[i];
    }
    float* ss1 = (float*)(ws + WS_SS1);
    float* ss2 = (float*)(ws + WS_SS2);
    for (int i = bid * NTHREADS + tid; i < NQ; i += G * NTHREADS) { ss1[i] = 0.f; ss2[i] = 0.f; }
}

constexpr int BM = 256, BK = 64, HALF = 128, NXCD = 8, HT = HALF * BK;

__device__ __forceinline__ int lds_byte(int r, int c) {
    int st = (r >> 4) * 2 + (c >> 5), rr = r & 15, cc = c & 31, ob = rr * 64 + cc * 2;
    return st * 1024 + (ob ^ (((ob >> 9) & 1) << 5));
}
__device__ __forceinline__ void stage_rc(int b, int& R, int& C) {
    int st = b / 1024, sb = b % 1024, swz = sb ^ (((sb >> 9) & 1) << 5);
    R = (st >> 1) * 16 + swz / 64; C = (st & 1) * 32 + (swz % 64) / 2;
}

enum { EPI_PROJ = 0, EPI_T1 = 1, EPI_MIX = 2, EPI_H1 = 3, EPI_GU = 4, EPI_DOWN = 5 };

struct EpiArgs {
    unsigned char* ws;
    const float* x;
    float* out;
};

template <int EPI, int M, int N, int K>
__device__ __forceinline__ void gemm_phase(const u16* __restrict__ A, const u16* __restrict__ Bt,
                           const EpiArgs ea, unsigned char* ldsraw, const u16* __restrict__ A2 = nullptr, const u16* __restrict__ Bt2 = nullptr) {
    u16* shm = reinterpret_cast<u16*>(ldsraw);
#define SA(b, h) (shm + ((b) * 2 + (h)) * HT)
#define SB(b, h) (shm + (4 + (b) * 2 + (h)) * HT)
#define SAO(b, h) ((unsigned)(((b) * 2 + (h)) * HT * 2))
#define SBO(b, h) ((unsigned)((4 + (b) * 2 + (h)) * HT * 2))
#define STAGE(SLOTOFF, BASE, br, kt) do { const u16* _gp = (BASE) + (long)(br) * K + (long)(kt) * BK; \
    const unsigned _m0 = lds_wave_base + (SLOTOFF); \
    asm volatile("s_mov_b32 m0, %0\n\ts_nop 0\n\tglobal_load_lds_dwordx4 %1, %2" :: "s"(_m0), "v"(voff), "s"(_gp) : "memory"); \
    asm volatile("s_mov_b32 m0, %0\n\ts_nop 0\n\tglobal_load_lds_dwordx4 %1, %2" :: "s"(_m0 + 8192u), "v"(voff), "s"(_gp + 64 * K) : "memory"); } while (0)
#define LDA(dst, b, h) for (int m = 0; m < 4; ++m) for (int k = 0; k < 2; ++k) \
    dst[m][k] = *reinterpret_cast<const bf16x8*>((char*)SA(b, h) + lds_byte(wr * 64 + m * 16 + fr, k * 32 + fq * 8))
#define LDB(dst, b, h) for (int n = 0; n < 2; ++n) for (int k = 0; k < 2; ++k) \
    dst[n][k] = *reinterpret_cast<const bf16x8*>((char*)SB(b, h) + lds_byte(wc * 32 + n * 16 + fr, k * 32 + fq * 8))
#define MMA(ai, bj, At, Bq) do { __builtin_amdgcn_s_setprio(1); \
    for (int m = 0; m < 4; ++m) for (int n = 0; n < 2; ++n) for (int k = 0; k < 2; ++k) \
      acc[ai][bj][m][n] = __builtin_amdgcn_mfma_f32_16x16x32_bf16(At[m][k], Bq[n][k], acc[ai][bj][m][n], 0, 0, 0); \
    __builtin_amdgcn_s_setprio(0); } while (0)
#define WAIT_V(n) asm volatile("s_waitcnt vmcnt(" #n ")" ::: "memory")
#define WAIT_L(n) asm volatile("s_waitcnt lgkmcnt(" #n ")" ::: "memory")
#define BAR __builtin_amdgcn_s_barrier()
#define SCHED __builtin_amdgcn_sched_barrier(0)

    constexpr int nM = M / BM, nN = N / BM, nwg = nM * nN;
    const int gtid = tid_fresh();
    unsigned voff;
    { int _r, _c; stage_rc(gtid * 16, _r, _c); voff = (unsigned)((_r * K + _c) * 2); }
    const unsigned lds_wave_base = __builtin_amdgcn_readfirstlane(
        (unsigned)(unsigned long long)(__attribute__((address_space(3))) unsigned char*)ldsraw + (unsigned)(gtid >> 6) * 1024u);
    const int wid = gtid >> 6, lane = gtid & 63, wr = wid >> 2, wc = wid & 3, fr = lane & 15, fq = lane >> 4;
    constexpr int nt = K / BK;
    constexpr int WGM = (EPI == EPI_PROJ) ? 2 : 8;
#define TILE_RC(T, PM, PN) do { int wgid_ = (T); \
        { int q = nwg / NXCD, r = nwg % NXCD, xcd = wgid_ % NXCD, off = wgid_ / NXCD; \
          wgid_ = (xcd < r ? xcd * (q + 1) : r * (q + 1) + (xcd - r) * q) + off; } \
        constexpr int nig = WGM * nN; const int gid = wgid_ / nig, fm = gid * WGM, gsz = min(nM - fm, WGM); \
        PM = fm + ((wgid_ % nig) % gsz); PN = (wgid_ % nig) / gsz; } while (0)
    constexpr bool PREFETCH_NEXT = (EPI != EPI_PROJ);
    bool prefetched = false;
    for (int tile = blockIdx.x; tile < nwg; tile += gridDim.x) {
        int pm, pn;
        TILE_RC(tile, pm, pn);
        const int brow = pm * BM, bcol = pn * BM;
        f32x4 acc[2][2][4][2] = {};
        bf16x8 At[4][2], B0[2][2], B1[2][2];
        constexpr int NPASS = (EPI == EPI_MIX) ? 2 : 1;
#pragma unroll 1
        for (int pass = 0; pass < NPASS; ++pass) {
        const u16* Ap = pass ? A2 : A;
        const u16* Bp = pass ? Bt2 : Bt;
        if (!(prefetched && pass == 0)) {
            STAGE(SBO(0, 0), Bp, bcol, 0); STAGE(SAO(0, 0), Ap, brow, 0);
            STAGE(SBO(0, 1), Bp, bcol + HALF, 0); STAGE(SAO(0, 1), Ap, brow + HALF, 0);
        }
        if (wr == 1) BAR;
        WAIT_V(4); BAR;
        STAGE(SBO(1, 0), Bp, bcol, 1); STAGE(SAO(1, 0), Ap, brow, 1); STAGE(SBO(1, 1), Bp, bcol + HALF, 1);
        WAIT_V(6); BAR;
        for (int t = 0; t < nt - 2; t += 2) {
            LDB(B0, 0, 0); SCHED; LDA(At, 0, 0); STAGE(SAO(1, 1), Ap, brow + HALF, t + 1);
            WAIT_L(8); BAR; WAIT_L(0); MMA(0, 0, At, B0); BAR; SCHED;
            LDB(B1, 0, 1); STAGE(SBO(0, 0), Bp, bcol, t + 2);
            BAR; WAIT_L(0); MMA(0, 1, At, B1); BAR;
            LDA(At, 0, 1); STAGE(SAO(0, 0), Ap, brow, t + 2);
            BAR; WAIT_L(0); MMA(1, 0, At, B0); BAR; SCHED;
            STAGE(SBO(0, 1), Bp, bcol + HALF, t + 2);
            WAIT_V(6); BAR; MMA(1, 1, At, B1); BAR;
            LDB(B0, 1, 0); SCHED; LDA(At, 1, 0); STAGE(SAO(0, 1), Ap, brow + HALF, t + 2);
            WAIT_L(8); BAR; WAIT_L(0); MMA(0, 0, At, B0); BAR; SCHED;
            LDB(B1, 1, 1); STAGE(SBO(1, 0), Bp, bcol, t + 3);
            BAR; WAIT_L(0); MMA(0, 1, At, B1); BAR;
            LDA(At, 1, 1); STAGE(SAO(1, 0), Ap, brow, t + 3);
            BAR; WAIT_L(0); MMA(1, 0, At, B0); BAR; SCHED;
            STAGE(SBO(1, 1), Bp, bcol + HALF, t + 3);
            WAIT_V(6); BAR; MMA(1, 1, At, B1); BAR;
        }
        { LDB(B0, 0, 0); LDA(At, 0, 0); STAGE(SAO(1, 1), Ap, brow + HALF, nt - 1);
          BAR; WAIT_L(0); MMA(0, 0, At, B0); BAR;
          LDB(B1, 0, 1); BAR; WAIT_L(0); MMA(0, 1, At, B1); BAR;
          LDA(At, 0, 1); WAIT_V(4); BAR; WAIT_L(0); MMA(1, 0, At, B0); MMA(1, 1, At, B1); BAR; }
        { LDB(B0, 1, 0); LDA(At, 1, 0); WAIT_V(2); BAR; WAIT_L(0); MMA(0, 0, At, B0); BAR;
          LDB(B1, 1, 1); WAIT_V(0); BAR; WAIT_L(0); MMA(0, 1, At, B1); BAR;
          LDA(At, 1, 1); BAR; WAIT_L(0); MMA(1, 0, At, B0); MMA(1, 1, At, B1); BAR; }
        if (wr == 0) BAR;
        if (NPASS == 2 && pass == 0) {
            int s_row0 = wr * 64 + fq * 4, s_lc0 = wc * 32 + fr;
            asm volatile("" : "+v"(s_row0), "+v"(s_lc0));
#pragma unroll
            for (int ai = 0; ai < 2; ++ai)
#pragma unroll
            for (int m = 0; m < 4; ++m)
#pragma unroll
            for (int j = 0; j < 4; ++j) {
                const size_t ro = (size_t)(brow + ai * HALF + s_row0 + m * 16 + j) * D + bcol + s_lc0;
                const u16* ga = (const u16*)ea.out + ro;
                const u16* gb = (const u16*)ea.out + (size_t)NQ * D + ro;
#pragma unroll
                for (int bj = 0; bj < 2; ++bj)
#pragma unroll
                for (int n = 0; n < 2; ++n)
                    acc[ai][bj][m][n][j] *= bflo(ga[bj * 128 + n * 16]) * __builtin_amdgcn_rcpf(bflo(gb[bj * 128 + n * 16]));
            }
            __syncthreads();
        }
        }
        prefetched = false;
        if (PREFETCH_NEXT && tile + (int)gridDim.x < nwg) {
            int pm2, pn2;
            TILE_RC(tile + (int)gridDim.x, pm2, pn2);
            const int brow2 = pm2 * BM, bcol2 = pn2 * BM;
            STAGE(SBO(0, 0), Bt, bcol2, 0); STAGE(SAO(0, 0), A, brow2, 0);
            STAGE(SBO(0, 1), Bt, bcol2 + HALF, 0); STAGE(SAO(0, 1), A, brow2 + HALF, 0);
            prefetched = true;
        }

        unsigned char* ws = ea.ws;
        int e_row0 = wr * 64 + fq * 4, e_lc0 = wc * 32 + fr;
        asm volatile("" : "+v"(e_row0), "+v"(e_lc0));
        bool staged_done = false;
        if constexpr (EPI == EPI_PROJ) {
            if (pn != 34) {
                staged_done = true;
                const bool is8 = (pn >= 4 && pn < 12);
                const bool isP = (pn >= 12 && pn < 20);
                const bool isG = (pn >= 24 && pn < 32);
                int e_tid = gtid;
                asm volatile("" : "+v"(e_tid));
#define PROJ_STAGE2(CPR, STRIDE) do { \
                    for (int pc = e_tid; pc < 128 * (CPR); pc += NTHREADS) { \
                        const int r = pc / (CPR), cc = pc - r * (CPR); \
                        const int row = brow + ai * HALF + r; \
                        if (row < TOK) { \
                            const int b = row >= LTOK ? 1 : 0, pos = row - b * LTOK; \
                            const bool isq = pos >= NMETA; \
                            const size_t qn = (size_t)b * SEQ + (pos - NMETA); \
                            const uint4 v = *reinterpret_cast<const uint4*>(ldsraw + r * (STRIDE) + cc * 16); \
                            unsigned char* dst = nullptr; \
                            if (pn < 4) { if (isq) dst = ws + WS_Q + (qn * D + pn * 256 + cc * 8) * 2; } \
                            else if (pn < 12) { const int head = (pn & 3) * 2 + (cc >> 3); \
                                dst = ws + (pn < 8 ? WS_K8 : WS_V8) + ((size_t)(b * 8 + head) * LTOK + pos) * 128 + (cc & 7) * 16; } \
                            else if (pn < 20) dst = ws + WS_P + ((size_t)row * D + (pn - 12) * 128 + cc * 8) * 2; \
                            else if (pn < 24) { if (isq) dst = ws + WS_CB + (qn * D + (pn - 20) * 256 + cc * 8) * 2; } \
                            else if (pn < 32) { if (isq) dst = (unsigned char*)ea.out + ((size_t)(pn >= 28 ? 1 : 0) * NQ * D + qn * D + (pn & 3) * 256 + cc * 8) * 2; } \
                            else { if (isq) dst = ws + WS_QI + (qn * 512 + (pn - 32) * 256 + cc * 8) * 2; } \
                            if (dst) { typedef unsigned u32x4 __attribute__((ext_vector_type(4))); u32x4 vv = {v.x, v.y, v.z, v.w}; \
                                __builtin_nontemporal_store(vv, reinterpret_cast<u32x4*>(dst)); } \
                        } } } while (0)
#pragma unroll
                for (int ai = 0; ai < 2; ++ai) {
                    if (is8) {
#pragma unroll
                        for (int m = 0; m < 4; ++m)
#pragma unroll
                        for (int j = 0; j < 4; ++j) {
                            unsigned char* d = ldsraw + (e_row0 + m * 16 + j) * 272 + e_lc0;
#pragma unroll
                            for (int bj = 0; bj < 2; ++bj)
#pragma unroll
                            for (int n = 0; n < 2; ++n) {
                                const float v = acc[ai][bj][m][n][j];
                                d[bj * 128 + n * 16] = (unsigned char)(__builtin_amdgcn_cvt_pk_fp8_f32(v, v, 0, false) & 0xFF);
                            }
                        }
                    } else if (isP) {
#pragma unroll
                        for (int m = 0; m < 4; ++m)
#pragma unroll
                        for (int j = 0; j < 4; ++j) {
                            u16* d = reinterpret_cast<u16*>(ldsraw + (e_row0 + m * 16 + j) * 544) + e_lc0;
#pragma unroll
                            for (int n = 0; n < 2; ++n) d[n * 16] = f2bf(acc[ai][0][m][n][j] * acc[ai][1][m][n][j]);
                        }
                    } else {
#pragma unroll
                        for (int m = 0; m < 4; ++m)
#pragma unroll
                        for (int j = 0; j < 4; ++j) {
                            u16* d = reinterpret_cast<u16*>(ldsraw + (e_row0 + m * 16 + j) * 544) + e_lc0;
#pragma unroll
                            for (int bj = 0; bj < 2; ++bj)
#pragma unroll
                            for (int n = 0; n < 2; ++n) {
                                float v = acc[ai][bj][m][n][j];
                                if (isG) v = sigmoidf_(v);
                                d[bj * 128 + n * 16] = f2bf(v);
                            }
                        }
                    }
                    __syncthreads();
                    if (is8) PROJ_STAGE2(16, 272); else if (isP) PROJ_STAGE2(16, 544); else PROJ_STAGE2(32, 544);
                    __syncthreads();
                }
#undef PROJ_STAGE2
            }
        }
        if (!staged_done)
#pragma unroll
        for (int ai = 0; ai < 2; ++ai)
#pragma unroll
        for (int m = 0; m < 4; ++m)
#pragma unroll
        for (int j = 0; j < 4; ++j) {
            const int row = brow + ai * HALF + e_row0 + m * 16 + j;
            const int lc0 = e_lc0;
            if constexpr (EPI == EPI_PROJ) {
                if (row < TOK) {
                    const int b = row / LTOK, pos = row - b * LTOK;
                    const bool isq = pos >= NMETA;
                    const size_t qn = (size_t)b * SEQ + (pos - NMETA);
                    if (pn < 4) {
                        if (isq) {
                            u16* d = (u16*)(ws + WS_Q) + qn * D + pn * 256 + lc0;
#pragma unroll
                            for (int bj = 0; bj < 2; ++bj)
#pragma unroll
                            for (int n = 0; n < 2; ++n) d[bj * 128 + n * 16] = f2bf(acc[ai][bj][m][n][j]);
                        }
                    } else if (pn < 12) {
                        unsigned char* base = ws + (pn < 8 ? WS_K8 : WS_V8);
#pragma unroll
                        for (int bj = 0; bj < 2; ++bj) {
                            const int head = (pn & 3) * 2 + bj;
                            unsigned char* d = base + ((size_t)(b * 8 + head) * LTOK + pos) * 128 + lc0;
#pragma unroll
                            for (int n = 0; n < 2; ++n) {
                                const float v = acc[ai][bj][m][n][j];
                                d[n * 16] = (unsigned char)(__builtin_amdgcn_cvt_pk_fp8_f32(v, v, 0, false) & 0xFF);
                            }
                        }
                    } else if (pn < 20) {
                        u16* d = (u16*)(ws + WS_P) + (size_t)row * D + (pn - 12) * 128 + lc0;
#pragma unroll
                        for (int n = 0; n < 2; ++n) d[n * 16] = f2bf(acc[ai][0][m][n][j] * acc[ai][1][m][n][j]);
                    } else if (pn < 32) {
                        if (isq) {
                            if (pn < 24) {
                                u16* d = (u16*)(ws + WS_CB) + qn * D + (pn - 20) * 256 + lc0;
#pragma unroll
                                for (int bj = 0; bj < 2; ++bj)
#pragma unroll
                                for (int n = 0; n < 2; ++n) d[bj * 128 + n * 16] = f2bf(acc[ai][bj][m][n][j]);
                            } else {
                                u16* d = (u16*)ea.out + (size_t)(pn >= 28 ? 1 : 0) * NQ * D + qn * D + (pn & 3) * 256 + lc0;
#pragma unroll
                                for (int bj = 0; bj < 2; ++bj)
#pragma unroll
                                for (int n = 0; n < 2; ++n) d[bj * 128 + n * 16] = f2bf(sigmoidf_(acc[ai][bj][m][n][j]));
                            }
                        }
                    } else if (pn < 34) {
                        if (isq) {
                            u16* d = (u16*)(ws + WS_QI) + qn * 512 + (pn - 32) * 256 + lc0;
#pragma unroll
                            for (int bj = 0; bj < 2; ++bj)
#pragma unroll
                            for (int n = 0; n < 2; ++n) d[bj * 128 + n * 16] = f2bf(acc[ai][bj][m][n][j]);
                        }
                    } else {
#pragma unroll
                        for (int n = 0; n < 2; ++n) {
                            const int lc = lc0 + n * 16;
                            const float v = acc[ai][0][m][n][j];
                            if (lc < 64) ((u16*)(ws + WS_KI))[(size_t)row * 64 + lc] = f2bf(v);
                            else if (lc < 72 && isq) ((float*)(ws + WS_WI))[qn * 8 + (lc - 64)] = v * IDX_SCALE;
                        }
                    }
                }
            } else if constexpr (EPI == EPI_T1) {
                const u16* ga = (const u16*)ea.out + (size_t)row * D + bcol + lc0;
                float* d = (float*)(ws + WS_K) + (size_t)row * D + bcol + lc0;
#pragma unroll
                for (int bj = 0; bj < 2; ++bj)
#pragma unroll
                for (int n = 0; n < 2; ++n) d[bj * 128 + n * 16] = bflo(ga[bj * 128 + n * 16]) * acc[ai][bj][m][n][j];
            } else if constexpr (EPI == EPI_MIX) {
                const u16* gb = (const u16*)ea.out + (size_t)NQ * D + (size_t)row * D + bcol + lc0;
                u16* d = (u16*)(ws + WS_P) + (size_t)row * D + bcol + lc0;
#pragma unroll
                for (int bj = 0; bj < 2; ++bj)
#pragma unroll
                for (int n = 0; n < 2; ++n)
                    d[bj * 128 + n * 16] = f2bf(bflo(gb[bj * 128 + n * 16]) * acc[ai][bj][m][n][j]);
            } else if constexpr (EPI == EPI_H1) {
                const float* xr = ea.x + (size_t)row * D + bcol + lc0;
                u16* hb = (u16*)(ws + WS_CB) + (size_t)row * D + bcol + lc0;
                float ss = 0.f;
#pragma unroll
                for (int bj = 0; bj < 2; ++bj)
#pragma unroll
                for (int n = 0; n < 2; ++n) {
                    float v = xr[bj * 128 + n * 16] + acc[ai][bj][m][n][j];
                    hb[bj * 128 + n * 16] = f2bf(v);
                    ss += v * v;
                }
                ss += __shfl_xor(ss, 1); ss += __shfl_xor(ss, 2); ss += __shfl_xor(ss, 4); ss += __shfl_xor(ss, 8);
                if ((e_lc0 & 15) == 0) atomicAdd((float*)(ws + WS_SS1) + row, ss);
            } else if constexpr (EPI == EPI_GU) {
                const float rstd = rsqrtf(((const float*)(ws + WS_SS1))[row] * (1.f / D) + EPS);
                u16* d = (u16*)(ws + WS_ACT) + (size_t)row * DFF + pn * 128 + lc0;
#pragma unroll
                for (int n = 0; n < 2; ++n) {
                    float g = acc[ai][0][m][n][j] * rstd, u = acc[ai][1][m][n][j] * rstd;
                    d[n * 16] = f2bf(g * sigmoidf_(g) * u);
                }
            } else if constexpr (EPI == EPI_DOWN) {
                float* d = ea.out + (size_t)row * D + bcol + lc0;
                const u16* hb = (const u16*)(ws + WS_CB) + (size_t)row * D + bcol + lc0;
                float ss = 0.f;
#pragma unroll
                for (int bj = 0; bj < 2; ++bj)
#pragma unroll
                for (int n = 0; n < 2; ++n) {
                    float v = bflo(hb[bj * 128 + n * 16]) + acc[ai][bj][m][n][j];
                    d[bj * 128 + n * 16] = v;
                    ss += v * v;
                }
                ss += __shfl_xor(ss, 1); ss += __shfl_xor(ss, 2); ss += __shfl_xor(ss, 4); ss += __shfl_xor(ss, 8);
                if ((e_lc0 & 15) == 0) atomicAdd((float*)(ws + WS_SS2) + row, ss);
            }
        }
        __syncthreads();
    }
#undef TILE_RC
#undef SA
#undef SB
#undef SAO
#undef SBO
#undef STAGE
#undef LDA
#undef LDB
#undef MMA
}

constexpr int BIN_BASE = 117 << 5, BIN_TOP = (133 << 5) - 1;
__device__ __forceinline__ int score_bin(float x) {
    unsigned u = __float_as_uint(x);
    int e = (int)((u & 0x7FFFFFFFu) >> 18);
    e = min(max(e, BIN_BASE), BIN_TOP) - BIN_BASE;
    return (u >> 31) ? (511 - e) : (512 + e);
}
typedef float f32x2 __attribute__((ext_vector_type(2)));
__device__ __forceinline__ float bin_lower_edge(int bin) {
    if (bin < 0) return -INFINITY;
    if (bin >= 512) { const int m = bin - 512; return m == 0 ? 0.f : __uint_as_float((unsigned)(m + BIN_BASE) << 18); }
    const int m = 511 - bin;
    return (m == 511) ? -INFINITY : -__uint_as_float((unsigned)(m + 1 + BIN_BASE) << 18);
}
__device__ __forceinline__ float relu1(float x) { return __builtin_amdgcn_fmed3f(x, 0.f, __builtin_inff()); }

__device__ __forceinline__ void score_chunk(const bf16x8 (&ak)[2][2], const bf16x8 (&bq)[8][2], const bf16x8 (&bl)[2][2],
                                            const float (&wh)[8], float (&sc)[8]) {
#pragma unroll
    for (int sub = 0; sub < 2; ++sub) {
        f32x4 lin = {0.f, 0.f, 0.f, 0.f};
        lin = __builtin_amdgcn_mfma_f32_16x16x32_bf16(ak[sub][0], bl[0][0], lin, 0, 0, 0);
        lin = __builtin_amdgcn_mfma_f32_16x16x32_bf16(ak[sub][1], bl[0][1], lin, 0, 0, 0);
        lin = __builtin_amdgcn_mfma_f32_16x16x32_bf16(ak[sub][0], bl[1][0], lin, 0, 0, 0);
        lin = __builtin_amdgcn_mfma_f32_16x16x32_bf16(ak[sub][1], bl[1][1], lin, 0, 0, 0);
#pragma unroll
        for (int i = 0; i < 4; ++i) sc[sub * 4 + i] = lin[i];
    }
#pragma unroll
    for (int h = 0; h < 8; ++h) {
#pragma unroll
        for (int sub = 0; sub < 2; ++sub) {
            f32x4 acc = {0.f, 0.f, 0.f, 0.f};
            acc = __builtin_amdgcn_mfma_f32_16x16x32_bf16(ak[sub][0], bq[h][0], acc, 0, 0, 0);
            acc = __builtin_amdgcn_mfma_f32_16x16x32_bf16(ak[sub][1], bq[h][1], acc, 0, 0, 0);
#pragma unroll
            for (int i = 0; i < 4; ++i) sc[sub * 4 + i] = __builtin_fmaf(__builtin_fabsf(acc[i]), wh[h], sc[sub * 4 + i]);
        }
    }
}

struct IdxCtx {
    const u16* KIb; int l16, kq, ql, pos, wg, wave;
    unsigned* hist; int* nsel; int* ncand; float* candv; int* candi; u16* selq;
    unsigned ring_lds;
    const unsigned char* ring;
    unsigned dma_voff;
    unsigned long long* logq;
    int* nlog;
};
constexpr int LOGCAP = 1024;

template <int PASS, bool LOG = false>
__device__ __forceinline__ void idx_chunks(const IdxCtx& cx, const int cbeg, const int cend, const bf16x8 (&bq)[8][2],
                                           const bf16x8 (&bl)[2][2], const float (&w)[8], const float thr, const int mytb) {
    const int nIter = (cend - cbeg + 3) >> 2;
    if (nIter <= 0) return;
    const unsigned char* gsrc = reinterpret_cast<const unsigned char*>(cx.KIb) + (size_t)cbeg * 4096 + (size_t)cx.wave * 2048;
#define IDX_DMA(stage) do { const int _st = min((stage), nIter - 1); \
        const unsigned char* _g = gsrc + (size_t)_st * 16384; \
        const unsigned _m0 = cx.ring_lds + (unsigned)(((stage) & 3) * 16384 + cx.wave * 2048); \
        asm volatile("s_mov_b32 m0, %0\n\ts_nop 0\n\tglobal_load_lds_dwordx4 %1, %2" :: "s"(_m0), "v"(cx.dma_voff), "s"(_g) : "memory"); \
        asm volatile("s_mov_b32 m0, %0\n\ts_nop 0\n\tglobal_load_lds_dwordx4 %1, %2" :: "s"(_m0 + 1024u), "v"(cx.dma_voff), "s"(_g + 1024) : "memory"); } while (0)
    IDX_DMA(0); IDX_DMA(1); IDX_DMA(2);
#pragma unroll 1
    for (int i = 0; i < nIter; ++i) {
        asm volatile("s_waitcnt vmcnt(4)" ::: "memory");
        __builtin_amdgcn_s_barrier();
        IDX_DMA(i + 3);
        const int c = cbeg + 4 * i + cx.wg;
        if (c < cend) {
            const unsigned char* slot = cx.ring + (i & 3) * 16384 + cx.wg * 4096;
            bf16x8 ak[2][2];
#pragma unroll
            for (int sub = 0; sub < 2; ++sub)
#pragma unroll
            for (int ks = 0; ks < 2; ++ks) {
                const int key = sub * 16 + cx.l16, piece = ks * 4 + cx.kq;
                ak[sub][ks] = *reinterpret_cast<const bf16x8*>(slot + key * 128 + ((piece ^ (key & 7)) * 16));
            }
            float sc[8];
            score_chunk(ak, bq, bl, w, sc);
#pragma unroll
            for (int e = 0; e < 8; ++e) {
                const int s = 32 * c + 16 * (e >> 2) + 4 * cx.kq + (e & 3);
                if (s <= cx.pos && sc[e] >= thr) {
                    const int bin = score_bin(sc[e]);
                    if (PASS == 1) {
                        atomicAdd(&cx.hist[cx.ql * 512 + (bin >> 1)], 1u << ((bin & 1) * 16));
                        if (LOG) {
                            const int ls = atomicAdd(&cx.nlog[cx.ql], 1);
                            if (ls < LOGCAP) cx.logq[ls] = (unsigned long long)__float_as_uint(sc[e]) | ((unsigned long long)(unsigned)s << 32);
                        }
                    } else {
                        if (bin > mytb) {
                            const int slot2 = atomicAdd(&cx.nsel[cx.ql], 1);
                            if (slot2 < 256) cx.selq[slot2] = (u16)s;
                        } else if (bin == mytb) {
                            const int cidx = atomicAdd(&cx.ncand[cx.ql], 1);
                            if (cidx < 256) { cx.candv[cx.ql * 256 + cidx] = sc[e]; cx.candi[cx.ql * 256 + cidx] = s; }
                        }
                    }
                }
            }
        }
    }
    asm volatile("s_waitcnt vmcnt(0)" ::: "memory");
    __syncthreads();
#undef IDX_DMA
}

__device__ __forceinline__ void idx_threshold_scan(const unsigned* hist, int* tbv, int* cabv, const int wave, const int lane) {
#pragma unroll 1
    for (int qq = 0; qq < 4; ++qq) {
        const int q = wave * 4 + qq;
        const unsigned* hq = hist + q * 512 + lane * 8;
        unsigned wd[8];
        int mine = 0;
#pragma unroll
        for (int i = 0; i < 8; ++i) { wd[i] = hq[i]; mine += (int)(wd[i] & 0xFFFFu) + (int)(wd[i] >> 16); }
        int suf = mine;
#pragma unroll
        for (int o = 1; o < 64; o <<= 1) { int t = __shfl_down(suf, o); if (lane + o < 64) suf += t; }
        const unsigned long long mk = __ballot(suf >= 256);
        if (mk == 0ull) { if (lane == 0) { tbv[q] = -1; cabv[q] = 0; } }
        else {
            const int ls = 63 - __clzll((long long)mk);
            if (lane == ls) {
                int cum = suf - mine, tb = lane * 16, cab = cum;
                bool found = false;
#pragma unroll
                for (int i = 7; i >= 0; --i) {
                    const int chi = (int)(wd[i] >> 16), clo = (int)(wd[i] & 0xFFFFu);
                    if (!found) { if (cum + chi >= 256) { tb = lane * 16 + 2 * i + 1; cab = cum; found = true; } else cum += chi; }
                    if (!found) { if (cum + clo >= 256) { tb = lane * 16 + 2 * i; cab = cum; found = true; } else cum += clo; }
                }
                tbv[q] = tb; cabv[q] = cab;
            }
        }
    }
}

__device__ __forceinline__ void indexer_phase(const Params& p, unsigned char* lds) {
    unsigned char* ws = p.ws;
    const u16* QI = (const u16*)(ws + WS_QI);
    const u16* KI = (const u16*)(ws + WS_KI);
    const float* WI = (const float*)(ws + WS_WI);
    u16* SEL = (u16*)(ws + WS_SEL);
    unsigned* hist = reinterpret_cast<unsigned*>(lds);
    float* candv = reinterpret_cast<float*>(lds);
    int* candi = reinterpret_cast<int*>(lds + 32768);
    int* misc = reinterpret_cast<int*>(lds + 131072);
    int* nsel = misc; int* ncand = misc + 32; int* tbv = misc + 64; int* cabv = misc + 96; int* nlog = misc + 128;
    const int tid = tid_fresh(), lane = tid & 63, wave = tid >> 6;
    const int l16 = lane & 15, kq = lane >> 4;
    const int grp = wave >> 2, wg = wave & 3;
    const int ql = grp * 16 + l16;
    const int G = gridDim.x, bid = blockIdx.x;
    constexpr int NT = NQ / 32;
    IdxCtx cx;
    cx.l16 = l16; cx.kq = kq; cx.ql = ql; cx.wg = wg; cx.wave = __builtin_amdgcn_readfirstlane(wave);
    cx.hist = hist; cx.nsel = nsel; cx.ncand = ncand; cx.candv = candv; cx.candi = candi; cx.nlog = nlog;
    unsigned long long* const logbase = reinterpret_cast<unsigned long long*>(ws + WS_A0) + (size_t)bid * 32 * LOGCAP;
    cx.logq = logbase + (size_t)ql * LOGCAP;
    cx.ring = lds + 65536;
    cx.ring_lds = __builtin_amdgcn_readfirstlane((unsigned)(unsigned long long)(__attribute__((address_space(3))) unsigned char*)lds + 65536u);
    cx.dma_voff = (unsigned)((lane >> 3) * 128 + (((lane & 7) ^ (lane >> 3)) * 16));
    for (int it = 0; it * G < NT; ++it) {
        const int r = it * G + ((it & 1) ? (G - 1 - bid) : bid);
        if (r >= NT) continue;
        const int b = r & 1, idx = (NT / 2 - 1) - (r >> 1);
        const int p0 = NMETA + 32 * idx;
        const size_t qn0 = (size_t)b * SEQ + 32 * idx;
        const int nch = idx + 2;
        cx.KIb = KI + (size_t)b * LTOK * 64; cx.pos = p0 + ql;
        cx.selq = SEL + (qn0 + ql) * 256;
        bf16x8 bq[8][2];
        float w[8];
        {
            const u16* qp = QI + (qn0 + ql) * 512 + kq * 8;
#pragma unroll
            for (int h = 0; h < 8; ++h)
#pragma unroll
            for (int ks = 0; ks < 2; ++ks) bq[h][ks] = *reinterpret_cast<const bf16x8*>(qp + h * 64 + ks * 32);
#pragma unroll
            for (int h = 0; h < 8; ++h) w[h] = 0.5f * WI[(qn0 + ql) * 8 + h];
        }
        bf16x8 bl[2][2];
#pragma unroll
        for (int ks = 0; ks < 2; ++ks) {
            float qc[8];
#pragma unroll
            for (int j = 0; j < 8; ++j) qc[j] = 0.f;
#pragma unroll
            for (int h = 0; h < 8; ++h) {
                union { bf16x8 v; unsigned u[4]; } cv; cv.v = bq[h][ks];
#pragma unroll
                for (int j = 0; j < 4; ++j) { qc[2 * j] = fmaf(w[h], bflo(cv.u[j]), qc[2 * j]); qc[2 * j + 1] = fmaf(w[h], bfhi(cv.u[j]), qc[2 * j + 1]); }
            }
            union { bf16x8 v; unsigned u[4]; } hi, lo;
#pragma unroll
            for (int j = 0; j < 4; ++j) {
                const unsigned hp = pack2(qc[2 * j], qc[2 * j + 1]);
                hi.u[j] = hp;
                lo.u[j] = pack2(qc[2 * j] - bflo(hp), qc[2 * j + 1] - bfhi(hp));
            }
            bl[0][ks] = hi.v; bl[1][ks] = lo.v;
        }
        {
            uint4 z = {0u, 0u, 0u, 0u};
            for (int i = tid; i < 65536 / 16; i += NTHREADS) reinterpret_cast<uint4*>(lds)[i] = z;
            if (tid < 256) misc[tid] = 0;
        }
        __syncthreads();
        float thr = -INFINITY;
        constexpr int LOG0 = 64;
        idx_chunks<1, false>(cx, 0, min(nch, LOG0), bq, bl, w, thr, 0);
        if (nch > LOG0) {
            idx_threshold_scan(hist, tbv, cabv, wave, lane);
            __syncthreads();
            thr = bin_lower_edge(tbv[ql]);
            idx_chunks<1, true>(cx, LOG0, min(nch, 128), bq, bl, w, thr, 0);
            if (nch > 128) {
                idx_threshold_scan(hist, tbv, cabv, wave, lane);
                __syncthreads();
                thr = bin_lower_edge(tbv[ql]);
                idx_chunks<1, true>(cx, 128, min(nch, 256), bq, bl, w, thr, 0);
                if (nch > 256) {
                    idx_threshold_scan(hist, tbv, cabv, wave, lane);
                    __syncthreads();
                    thr = bin_lower_edge(tbv[ql]);
                    idx_chunks<1, true>(cx, 256, nch, bq, bl, w, thr, 0);
                }
            }
        }
        idx_threshold_scan(hist, tbv, cabv, wave, lane);
        __syncthreads();
        const int mytb = tbv[ql];
        const bool use_log = (nch > LOG0) && (__syncthreads_or(nlog[ql] > LOGCAP) == 0);
        idx_chunks<2, false>(cx, 0, use_log ? LOG0 : nch, bq, bl, w, bin_lower_edge(mytb), mytb);
        if (use_log) {
#pragma unroll 1
            for (int qq = 0; qq < 4; ++qq) {
                const int q = wave * 4 + qq;
                const int tb = tbv[q];
                const int n = nlog[q];
                const unsigned long long* lq = logbase + (size_t)q * LOGCAP;
                u16* so = SEL + (qn0 + q) * 256;
#pragma unroll 1
                for (int i = lane; i < n; i += 64) {
                    const unsigned long long ent = __hip_atomic_load(lq + i, __ATOMIC_RELAXED, __HIP_MEMORY_SCOPE_AGENT);
                    const float v = __uint_as_float((unsigned)ent);
                    const int ks = (int)(ent >> 32);
                    const int bin = score_bin(v);
                    if (bin > tb) {
                        const int slot2 = atomicAdd(&nsel[q], 1);
                        if (slot2 < 256) so[slot2] = (u16)ks;
                    } else if (bin == tb) {
                        const int cidx = atomicAdd(&ncand[q], 1);
                        if (cidx < 256) { candv[q * 256 + cidx] = v; candi[q * 256 + cidx] = ks; }
                    }
                }
            }
            __syncthreads();
        }
#pragma unroll 1
        for (int qq = 0; qq < 4; ++qq) {
            const int q = wave * 4 + qq;
            const int tb = tbv[q], cab = cabv[q];
            const int n = min(ncand[q], 256);
            const int need = (tb < 0) ? 0 : (256 - cab);
            u16* so = SEL + (qn0 + q) * 256;
            if (tb >= 0) {
#pragma unroll 1
                for (int i = lane; i < n; i += 64) {
                    const float vi = candv[q * 256 + i];
                    const int si = candi[q * 256 + i];
                    int rank = 0;
#pragma unroll 2
                    for (int jn = 0; jn < n; ++jn) {
                        const float vj = candv[q * 256 + jn];
                        const int sj = candi[q * 256 + jn];
                        rank += (vj > vi || (vj == vi && sj < si)) ? 1 : 0;
                    }
                    if (rank < need) so[cab + rank] = (u16)si;
                }
            }
            const int total = (tb < 0) ? min(nsel[q], 256) : min(256, cab + min(need, n));
            for (int s2 = total + lane; s2 < 256; s2 += 64) so[s2] = (u16)0xFFFFu;
        }
        __syncthreads();
    }
}

__device__ __forceinline__ void attn_conv_phase(const Params& p, unsigned char* lds, const bool do_attn, const bool do_conv) {
    unsigned char* ws = p.ws;
    const u16* QO = (const u16*)(ws + WS_Q);
    u16* OB = (u16*)(ws + WS_A0);
    const unsigned char* K8 = ws + WS_K8;
    const unsigned char* V8 = ws + WS_V8;
    const u16* SEL = (const u16*)(ws + WS_SEL);
    const int tid = tid_fresh(), lane = tid & 63, wave = tid >> 6;
    const int G = gridDim.x, bid = blockIdx.x;
    float* lg = reinterpret_cast<float*>(lds) + wave * 256;
    u16* selb = reinterpret_cast<u16*>(lds + 8192) + wave * 256;
    const int grp = lane >> 3, sub = lane & 7, quad = lane >> 4, n16 = lane & 15;
    const bool local = (G % 8) == 0;
    const int head_fixed = bid & 7;
    const int nitems = local ? NQ : NQ * 8;
    const int start = local ? ((bid >> 3) * 8 + wave) : (bid * 8 + wave);
    const int step = local ? (G >> 3) * 8 : G * 8;
    uint4 qnx[2][2] = {};
    uint2 svnx = {0u, 0u};
    if (do_attn && start < nitems) {
        const int qn_ = local ? start : (start >> 3), head_ = local ? head_fixed : (start & 7);
        const u16* qrow_ = QO + (size_t)qn_ * D + head_ * 128 + quad * 16;
#pragma unroll
        for (int hsel = 0; hsel < 2; ++hsel) { const uint4* qp_ = reinterpret_cast<const uint4*>(qrow_ + hsel * 64); qnx[hsel][0] = qp_[0]; qnx[hsel][1] = qp_[1]; }
        svnx = *reinterpret_cast<const uint2*>(SEL + (size_t)qn_ * 256 + lane * 4);
    }
    if (do_attn)
    for (int item = start; item < nitems; item += step) {
        const int qn = local ? item : (item >> 3);
        const int head = local ? head_fixed : (item & 7);
        const int b = qn >> 14;
        uint4 qcur[2][2];
#pragma unroll
        for (int hsel = 0; hsel < 2; ++hsel) { qcur[hsel][0] = qnx[hsel][0]; qcur[hsel][1] = qnx[hsel][1]; }
        *reinterpret_cast<uint2*>(selb + lane * 4) = svnx;
        if (item + step < nitems) {
            const int it2 = item + step;
            const int qn_ = local ? it2 : (it2 >> 3), head_ = local ? head_fixed : (it2 & 7);
            const u16* qrow_ = QO + (size_t)qn_ * D + head_ * 128 + quad * 16;
#pragma unroll
            for (int hsel = 0; hsel < 2; ++hsel) { const uint4* qp_ = reinterpret_cast<const uint4*>(qrow_ + hsel * 64); qnx[hsel][0] = qp_[0]; qnx[hsel][1] = qp_[1]; }
            svnx = *reinterpret_cast<const uint2*>(SEL + (size_t)qn_ * 256 + lane * 4);
        }
        long qa_hi[4], qa_lo[4];
        {
#pragma unroll
            for (int hsel = 0; hsel < 2; ++hsel) {
                const uint4 a = qcur[hsel][0], c = qcur[hsel][1];
                const unsigned uu[8] = {a.x, a.y, a.z, a.w, c.x, c.y, c.z, c.w};
#pragma unroll
                for (int s2 = 0; s2 < 2; ++s2) {
                    float f[8];
#pragma unroll
                    for (int i = 0; i < 4; ++i) { f[2 * i] = bflo(uu[s2 * 4 + i]); f[2 * i + 1] = bfhi(uu[s2 * 4 + i]); }
                    int h0 = __builtin_amdgcn_cvt_pk_fp8_f32(f[0], f[1], 0, false);
                    h0 = __builtin_amdgcn_cvt_pk_fp8_f32(f[2], f[3], h0, true);
                    int h1 = __builtin_amdgcn_cvt_pk_fp8_f32(f[4], f[5], 0, false);
                    h1 = __builtin_amdgcn_cvt_pk_fp8_f32(f[6], f[7], h1, true);
                    const f32x2 b0 = __builtin_amdgcn_cvt_pk_f32_fp8(h0, false), b1 = __builtin_amdgcn_cvt_pk_f32_fp8(h0, true);
                    const f32x2 b2 = __builtin_amdgcn_cvt_pk_f32_fp8(h1, false), b3 = __builtin_amdgcn_cvt_pk_f32_fp8(h1, true);
                    int l0 = __builtin_amdgcn_cvt_pk_fp8_f32((f[0] - b0.x) * 16.f, (f[1] - b0.y) * 16.f, 0, false);
                    l0 = __builtin_amdgcn_cvt_pk_fp8_f32((f[2] - b1.x) * 16.f, (f[3] - b1.y) * 16.f, l0, true);
                    int l1 = __builtin_amdgcn_cvt_pk_fp8_f32((f[4] - b2.x) * 16.f, (f[5] - b2.y) * 16.f, 0, false);
                    l1 = __builtin_amdgcn_cvt_pk_fp8_f32((f[6] - b3.x) * 16.f, (f[7] - b3.y) * 16.f, l1, true);
                    qa_hi[hsel * 2 + s2] = (long)(((unsigned long long)(unsigned)h1 << 32) | (unsigned)h0);
                    qa_lo[hsel * 2 + s2] = (long)(((unsigned long long)(unsigned)l1 << 32) | (unsigned)l0);
                }
            }
        }
        const size_t kslab = (size_t)(b * 8 + head) * LTOK * 128 + quad * 16;
        uint4 kbuf[2][4][2];
        bool kok[2][4];
#define LOADK(BUF, BT) do { _Pragma("unroll") for (int g = 0; g < 4; ++g) { \
            const int idx_ = selb[((BT) * 4 + g) * 16 + n16]; kok[BUF][g] = idx_ != 0xFFFF; \
            const unsigned char* kp_ = K8 + kslab + (size_t)(kok[BUF][g] ? idx_ : 0) * 128; \
            kbuf[BUF][g][0] = *reinterpret_cast<const uint4*>(kp_); kbuf[BUF][g][1] = *reinterpret_cast<const uint4*>(kp_ + 64); } } while (0)
        LOADK(0, 0);
#pragma unroll
        for (int bt = 0; bt < 4; ++bt) {
            if (bt < 3) LOADK((bt + 1) & 1, bt + 1);
#pragma unroll
            for (int g = 0; g < 4; ++g) {
                const uint4 k0 = kbuf[bt & 1][g][0], k1 = kbuf[bt & 1][g][1];
                const long kb[4] = {(long)(((unsigned long long)k0.y << 32) | k0.x), (long)(((unsigned long long)k0.w << 32) | k0.z),
                                    (long)(((unsigned long long)k1.y << 32) | k1.x), (long)(((unsigned long long)k1.w << 32) | k1.z)};
                f32x4 ah = {0.f, 0.f, 0.f, 0.f}, al = {0.f, 0.f, 0.f, 0.f};
#pragma unroll
                for (int s4 = 0; s4 < 4; ++s4) {
                    ah = __builtin_amdgcn_mfma_f32_16x16x32_fp8_fp8(qa_hi[s4], kb[s4], ah, 0, 0, 0);
                    al = __builtin_amdgcn_mfma_f32_16x16x32_fp8_fp8(qa_lo[s4], kb[s4], al, 0, 0, 0);
                }
                if (lane < 16) lg[(bt * 4 + g) * 16 + lane] = kok[bt & 1][g] ? (ah[0] + al[0] * 0.0625f) * ATT_SCALE : -INFINITY;
            }
        }
#undef LOADK
        const size_t slab = (size_t)(b * 8 + head) * LTOK * 128 + sub * 16;
        uint4 vbuf[2][8];
#define LOADV(BUF, BT) do { _Pragma("unroll") for (int i = 0; i < 8; ++i) { \
            const int idx_ = selb[((BT) * 8 + i) * 8 + grp]; \
            vbuf[BUF][i] = *reinterpret_cast<const uint4*>(V8 + slab + (size_t)(idx_ != 0xFFFF ? idx_ : 0) * 128); } } while (0)
        LOADV(0, 0);
        {
            float4 l4 = *reinterpret_cast<const float4*>(lg + lane * 4);
            float mx = fmaxf(fmaxf(l4.x, l4.y), fmaxf(l4.z, l4.w));
#pragma unroll
            for (int o = 32; o > 0; o >>= 1) mx = fmaxf(mx, __shfl_xor(mx, o));
            l4.x = __expf(l4.x - mx); l4.y = __expf(l4.y - mx); l4.z = __expf(l4.z - mx); l4.w = __expf(l4.w - mx);
            float sm = wave_sum(l4.x + l4.y + l4.z + l4.w);
            const float inv = 1.f / sm;
            l4.x *= inv; l4.y *= inv; l4.z *= inv; l4.w *= inv;
            *reinterpret_cast<float4*>(lg + lane * 4) = l4;
        }
        f32x2 o2[8];
#pragma unroll
        for (int i = 0; i < 8; ++i) { o2[i].x = 0.f; o2[i].y = 0.f; }
#pragma unroll
        for (int bt = 0; bt < 4; ++bt) {
            if (bt < 3) LOADV((bt + 1) & 1, bt + 1);
#pragma unroll
            for (int i = 0; i < 8; ++i) {
                const float pj = lg[(bt * 8 + i) * 8 + grp];
                const f32x2 pj2 = {pj, pj};
                const uint4 vv = vbuf[bt & 1][i];
                const unsigned uu[4] = {vv.x, vv.y, vv.z, vv.w};
#pragma unroll
                for (int e = 0; e < 4; ++e) {
                    const f32x2 lo = __builtin_amdgcn_cvt_pk_f32_fp8((int)uu[e], false);
                    const f32x2 hi = __builtin_amdgcn_cvt_pk_f32_fp8((int)uu[e], true);
                    o2[2 * e] = __builtin_elementwise_fma(lo, pj2, o2[2 * e]);
                    o2[2 * e + 1] = __builtin_elementwise_fma(hi, pj2, o2[2 * e + 1]);
                }
            }
        }
#undef LOADV
        float o[16];
#pragma unroll
        for (int i = 0; i < 8; ++i) { o[2 * i] = o2[i].x; o[2 * i + 1] = o2[i].y; }
#pragma unroll
        for (int i = 0; i < 16; ++i) { o[i] += __shfl_xor(o[i], 8); o[i] += __shfl_xor(o[i], 16); o[i] += __shfl_xor(o[i], 32); }
        if (grp == 0) {
            uint4 a, c;
            a.x = pack2(o[0], o[1]); a.y = pack2(o[2], o[3]); a.z = pack2(o[4], o[5]); a.w = pack2(o[6], o[7]);
            c.x = pack2(o[8], o[9]); c.y = pack2(o[10], o[11]); c.z = pack2(o[12], o[13]); c.w = pack2(o[14], o[15]);
            uint4* op = reinterpret_cast<uint4*>(OB + (size_t)qn * D + head * 128 + sub * 16);
            op[0] = a; op[1] = c;
        }
    }
    if (do_conv) {
        const u16* P = (const u16*)(ws + WS_P);
        u16* CB = (u16*)(ws + WS_CB);
        u16* U = CB;
        const int total = NQ * (D / 8);
        for (int e = bid * NTHREADS + tid; e < total; e += G * NTHREADS) {
            const int qn = e >> 7, c8 = (e & 127) * 8;
            const int b = qn >> 14;
            const size_t tok = (size_t)b * LTOK + NMETA + (qn & (SEQ - 1));
            const uint4 p0 = *reinterpret_cast<const uint4*>(P + (tok - 2) * D + c8);
            const uint4 p1 = *reinterpret_cast<const uint4*>(P + (tok - 1) * D + c8);
            const uint4 p2 = *reinterpret_cast<const uint4*>(P + tok * D + c8);
            const uint4 cb = *reinterpret_cast<const uint4*>(CB + (size_t)qn * D + c8);
            const unsigned a0[4] = {p0.x, p0.y, p0.z, p0.w}, a1[4] = {p1.x, p1.y, p1.z, p1.w}, a2[4] = {p2.x, p2.y, p2.z, p2.w},
                           ab[4] = {cb.x, cb.y, cb.z, cb.w};
            float w0[8], w1[8], w2[8];
#pragma unroll
            for (int i = 0; i < 8; ++i) { w0[i] = p.conv_w[c8 + i]; w1[i] = p.conv_w[D + c8 + i]; w2[i] = p.conv_w[2 * D + c8 + i]; }
            unsigned o[4];
#pragma unroll
            for (int i = 0; i < 4; ++i) {
                float lo = bflo(ab[i]) * (w0[2 * i] * bflo(a0[i]) + w1[2 * i] * bflo(a1[i]) + w2[2 * i] * bflo(a2[i]));
                float hi = bfhi(ab[i]) * (w0[2 * i + 1] * bfhi(a0[i]) + w1[2 * i + 1] * bfhi(a1[i]) + w2[2 * i + 1] * bfhi(a2[i]));
                o[i] = pack2(lo, hi);
            }
            uint4 ov = {o[0], o[1], o[2], o[3]};
            *reinterpret_cast<uint4*>(U + (size_t)qn * D + c8) = ov;
        }
    }
}

__device__ __forceinline__ void final_norm_phase(const Params& p) {
    const float* ss2 = (const float*)(p.ws + WS_SS2);
    const int ftid = tid_fresh();
    const int lane = ftid & 63, wave = ftid >> 6;
    for (int r = blockIdx.x * 8 + wave; r < NQ; r += gridDim.x * 8) {
        const float rstd = rsqrtf(ss2[r] * (1.f / D) + EPS);
        float* row = p.out + (size_t)r * D;
#pragma unroll
        for (int i = 0; i < 4; ++i) {
            float4 v = *reinterpret_cast<float4*>(row + i * 256 + lane * 4);
            const float4 g = *reinterpret_cast<const float4*>(p.g_final + i * 256 + lane * 4);
            v.x *= rstd * g.x; v.y *= rstd * g.y; v.z *= rstd * g.z; v.w *= rstd * g.w;
            *reinterpret_cast<float4*>(row + i * 256 + lane * 4) = v;
        }
    }
}

__device__ __forceinline__ void grid_bar(unsigned* ctr, unsigned& nbar) {
    __syncthreads();
    ++nbar;
    if (threadIdx.x == 0) {
        __builtin_amdgcn_fence(__ATOMIC_RELEASE, "agent");
        asm volatile("s_waitcnt vmcnt(0)" ::: "memory");
        __hip_atomic_fetch_add(ctr, 1u, __ATOMIC_RELAXED, __HIP_MEMORY_SCOPE_AGENT);
        const unsigned target = nbar * gridDim.x;
        while (__hip_atomic_load(ctr, __ATOMIC_RELAXED, __HIP_MEMORY_SCOPE_AGENT) < target) __builtin_amdgcn_s_sleep(1);
        __builtin_amdgcn_fence(__ATOMIC_ACQUIRE, "agent");
        asm volatile("s_waitcnt vmcnt(0)" ::: "memory");
    }
    __syncthreads();
}

__global__ void __launch_bounds__(NTHREADS, 2) fwd_megakernel(Params p) {
    extern __shared__ __attribute__((aligned(16))) unsigned char lds[];
    cg::grid_group grid = cg::this_grid();
    unsigned char* ws = p.ws;
    const int lo = p.ph_lo, hi = p.ph_hi;
    const EpiArgs ea{ws, p.x, p.out};
#define IN(k) (lo <= (k) && (k) < hi)
    unsigned nbar = 0;
    unsigned* bar_ctr = (unsigned*)(ws + WS_CTL);
#define SEAM(k) do { if (IN(k) && IN((k) + 1)) { if ((k) == 0) grid.sync(); else grid_bar(bar_ctr, nbar); } } while (0)
    if (IN(0)) phase_prep(p, lds);
    SEAM(0);
    if (IN(1)) gemm_phase<EPI_PROJ, TOKP, NPROJ, D>((const u16*)(ws + WS_A0), (const u16*)(ws + WS_WIN), ea, lds);
    SEAM(1);
    if (IN(2)) indexer_phase(p, lds);
    SEAM(2);
    if (IN(3)) attn_conv_phase(p, lds, true, true);
    SEAM(3);
    if (IN(5)) gemm_phase<EPI_MIX, NQ, D, D>((const u16*)(ws + WS_A0), (const u16*)(ws + WS_WA), ea, lds, (const u16*)(ws + WS_CB), (const u16*)(ws + WS_WC));
    SEAM(5);
    if (IN(6)) gemm_phase<EPI_H1, NQ, D, D>((const u16*)(ws + WS_P), (const u16*)(ws + WS_WO), ea, lds);
    SEAM(6);
    if (IN(7)) gemm_phase<EPI_GU, NQ, 2 * DFF, D>((const u16*)(ws + WS_CB), (const u16*)(ws + WS_WGU), ea, lds);
    SEAM(7);
    if (IN(8)) gemm_phase<EPI_DOWN, NQ, D, DFF>((const u16*)(ws + WS_ACT), (const u16*)(ws + WS_WD), ea, lds);
    SEAM(8);
    if (IN(9)) final_norm_phase(p);
#undef IN
#undef SEAM
}

extern "C" void kernel_launch(void* const* d_in, const int* in_sizes, int n_in, void* d_out, int out_size, void* d_ws,
                              size_t ws_size, hipStream_t stream) {
    static int grid_blocks = 0;
    if (grid_blocks == 0) {
        if (n_in != 13 || out_size != NQ * D || ws_size < WS_END) {
            fprintf(stderr, "kernel_launch: unexpected shapes (n_in %d out %d ws %zu need %zu)\n", n_in, out_size, ws_size, (size_t)WS_END);
            grid_blocks = -1; return;
        }
        int dev = 0, cus = 0, per_cu = 0;
        hipGetDevice(&dev);
        hipDeviceGetAttribute(&cus, hipDeviceAttributeMultiprocessorCount, dev);
        if (hipFuncSetAttribute((const void*)fwd_megakernel, hipFuncAttributeMaxDynamicSharedMemorySize, LDS_BYTES) != hipSuccess) {
            fprintf(stderr, "kernel_launch: hipFuncSetAttribute failed\n"); grid_blocks = -1; return;
        }
        hipOccupancyMaxActiveBlocksPerMultiprocessor(&per_cu, (const void*)fwd_megakernel, NTHREADS, LDS_BYTES);
        if (per_cu < 1) { fprintf(stderr, "kernel_launch: occupancy query says %d blocks/CU\n", per_cu); grid_blocks = -1; return; }
        grid_blocks = cus < 256 ? cus : 256;
    }
    if (grid_blocks < 0) return;
    if (hipMemsetAsync((unsigned char*)d_ws + WS_CTL, 0, 256, stream) != hipSuccess) { fprintf(stderr, "kernel_launch: memset failed\n"); return; }
    Params p{};
    p.x = (const float*)d_in[0]; p.meta = (const float*)d_in[1]; p.g_mix = (const float*)d_in[2]; p.w_in = (const float*)d_in[3];
    p.w_attn_out = (const float*)d_in[4]; p.conv_w = (const float*)d_in[5]; p.w_conv_out = (const float*)d_in[6];
    p.w_out = (const float*)d_in[7]; p.g_ffn = (const float*)d_in[8]; p.w_gate = (const float*)d_in[9]; p.w_up = (const float*)d_in[10];
    p.w_down = (const float*)d_in[11]; p.g_final = (const float*)d_in[12];
    p.out = (float*)d_out; p.ws = (unsigned char*)d_ws; p.ph_lo = 0; p.ph_hi = 10; p.probe = PROBE_MODE; p.pad = 0;
    void* args[] = {&p};
    hipError_t e = hipLaunchCooperativeKernel((const void*)fwd_megakernel, dim3(grid_blocks), dim3(NTHREADS), args, LDS_BYTES, stream);
    if (e != hipSuccess) fprintf(stderr, "cooperative launch failed: %s (grid %d)\n", hipGetErrorString(e), grid_blocks);
}
```
